# Optimizing an MI355X kernel written in HIP

```python
import jax, jax.numpy as jnp
from jax import lax
import numpy as np

D_MODEL = 1024
BATCH = 16
SEQ = 2048
DEPTH = 4

GRID_W = 64
CTX_LEN = 256
HEAD_DIM = 64
ROPE_THETA = 10000.0
EPS = 1e-6
ATTN_SCALE = HEAD_DIM ** -0.5
Q_BLOCK = 128

ATT_WIDTH = D_MODEL // 2
ATT_HEADS = ATT_WIDTH // HEAD_DIM
ATT_KV_HEADS = ATT_HEADS // 4
ATT_GROUP = ATT_HEADS // ATT_KV_HEADS
ATT_KV_WIDTH = ATT_KV_HEADS * HEAD_DIM
POOL_WINDOWS = (2, 4, 8, 16)
POOL_WIDTH = D_MODEL // 4
POOL_GROUP_DIM = POOL_WIDTH // len(POOL_WINDOWS)
NA_WIDTH = D_MODEL // 4
NA_HEADS = NA_WIDTH // HEAD_DIM
NA_KH_MAX = 8
NA_KW = 16

MIX_WIDTH = ATT_WIDTH + POOL_WIDTH + NA_WIDTH
IN_SPLITS = (ATT_WIDTH, ATT_KV_WIDTH, ATT_KV_WIDTH, ATT_WIDTH,
             POOL_WIDTH, POOL_WIDTH,
             NA_WIDTH, NA_WIDTH, NA_WIDTH, NA_WIDTH)
IN_OFFSETS = tuple(int(o) for o in np.cumsum((0,) + IN_SPLITS))
IN_WIDTH = IN_OFFSETS[-1]
SPLIT_POINTS = IN_OFFSETS[1:-1]

kernel_name = "hybrid_parallel_heads_diffusion_block"


def rms_norm(x, g):
    xf = x.astype(jnp.float32)
    y = xf * lax.rsqrt(jnp.mean(xf * xf, axis=-1, keepdims=True) + EPS)
    return (y * g.astype(jnp.float32)).astype(x.dtype)


def rope_axis(x, pos):
    half = x.shape[-1] // 2
    inv_freq = ROPE_THETA ** (-jnp.arange(half, dtype=jnp.float32) / half)
    ang = pos.astype(jnp.float32)[:, None] * inv_freq[None, :]
    cos = jnp.cos(ang)[None, :, None, :]
    sin = jnp.sin(ang)[None, :, None, :]
    xf = x.astype(jnp.float32)
    x1, x2 = xf[..., :half], xf[..., half:]
    return jnp.concatenate([x1 * cos - x2 * sin, x2 * cos + x1 * sin], axis=-1).astype(x.dtype)


def rope_2d(x, row, col):
    h = HEAD_DIM // 2
    return jnp.concatenate([rope_axis(x[..., :h], row), rope_axis(x[..., h:], col)], axis=-1)


def dense_attn(q, k, v):
    s = jnp.einsum("bqkgd,bskd->bkgqs", q, k).astype(jnp.float32)
    p = jax.nn.softmax(s, axis=-1).astype(v.dtype)
    o = jnp.einsum("bkgqs,bskd->bqkgd", p, v)
    return o.reshape(o.shape[0], o.shape[1], -1)


def global_gqa(q, k, v, k_ctx, v_ctx):
    bsz, seq = q.shape[:2]
    n_blk = seq // Q_BLOCK
    kk = jnp.concatenate([k, k_ctx], axis=1)
    vv = jnp.concatenate([v, v_ctx], axis=1)
    qb = jnp.moveaxis(q.reshape(bsz, n_blk, Q_BLOCK, ATT_KV_HEADS, ATT_GROUP, HEAD_DIM), 1, 0)
    o = lax.map(lambda qi: dense_attn(qi, kk, vv), qb)
    return jnp.moveaxis(o, 0, 1).reshape(bsz, seq, ATT_WIDTH)


def multi_pool(z):
    bsz, length, width = z.shape
    zf = z.astype(jnp.float32)
    cs = jnp.concatenate([jnp.zeros((bsz, 1, width), jnp.float32), jnp.cumsum(zf, axis=1)], axis=1)
    t = np.arange(length)
    outs = []
    for g, w in enumerate(POOL_WINDOWS):
        lo = np.maximum(t - w // 2, 0)
        hi = np.minimum(t + w // 2 - 1, length - 1)
        cnt = jnp.asarray((hi - lo + 1).astype(np.float32))[None, :, None]
        sl = slice(g * POOL_GROUP_DIM, (g + 1) * POOL_GROUP_DIM)
        seg = cs[:, :, sl]
        outs.append((seg[:, hi + 1] - seg[:, lo]) / cnt - zf[:, :, sl])
    return jnp.concatenate(outs, axis=-1).astype(z.dtype)


def pool_branch(z, w, s):
    bsz, length = z.shape[:2]
    pooled = multi_pool(z).reshape(bsz, length, len(POOL_WINDOWS), POOL_GROUP_DIM)
    y = jnp.einsum("blgi,gio->blgo", pooled, w).reshape(bsz, length, POOL_WIDTH)
    return y * s


def neighbourhood_attn(q, k, v, k_ctx, v_ctx, rpb, rows):
    bsz = q.shape[0]
    kh = min(NA_KH_MAX, rows)
    qg = q.reshape(bsz, rows, GRID_W, NA_HEADS, HEAD_DIM)
    kg = k.reshape(bsz, rows, GRID_W, NA_HEADS, HEAD_DIM)
    vg = v.reshape(bsz, rows, GRID_W, NA_HEADS, HEAD_DIM)
    c_idx = np.arange(GRID_W)
    c0 = np.clip(c_idx - NA_KW // 2, 0, GRID_W - NA_KW)
    cols = c0[:, None] + np.arange(NA_KW)[None, :]
    dcol = cols - c_idx[:, None] + NA_KW - 1
    n_nb = kh * NA_KW

    def row_block(r):
        r0 = jnp.clip(r - kh // 2, 0, rows - kh)
        k_band = lax.dynamic_slice_in_dim(kg, r0, kh, axis=1)
        v_band = lax.dynamic_slice_in_dim(vg, r0, kh, axis=1)
        k_nb = k_band[:, :, cols]
        v_nb = v_band[:, :, cols]
        q_r = lax.dynamic_index_in_dim(qg, r, axis=1, keepdims=False)
        s_nb = jnp.einsum("bqhd,bmqnhd->bhqmn", q_r, k_nb).astype(jnp.float32)
        drow = r0 + jnp.arange(kh) - r + NA_KH_MAX - 1
        bias = rpb[:, drow[:, None, None], dcol[None, :, :]]
        s_nb = s_nb + jnp.transpose(bias, (0, 2, 1, 3)).astype(jnp.float32)[None]
        s_ctx = jnp.einsum("bqhd,bchd->bhqc", q_r, k_ctx).astype(jnp.float32)
        s = jnp.concatenate([s_nb.reshape(bsz, NA_HEADS, GRID_W, n_nb), s_ctx], axis=-1)
        p = jax.nn.softmax(s, axis=-1).astype(v.dtype)
        p_nb = p[..., :n_nb].reshape(bsz, NA_HEADS, GRID_W, kh, NA_KW)
        p_ctx = p[..., n_nb:]
        return (jnp.einsum("bhqmn,bmqnhd->bqhd", p_nb, v_nb)
                + jnp.einsum("bhqc,bchd->bqhd", p_ctx, v_ctx))

    o = lax.map(row_block, jnp.arange(rows))
    return jnp.moveaxis(o, 0, 1).reshape(bsz, rows * GRID_W, NA_WIDTH)


def setup_inputs(seed: int = 0) -> dict:
    key = jax.random.key(seed)
    ks = jax.random.split(key, 16)
    f32 = jnp.float32
    n = lambda k, shape: jax.random.normal(k, shape, f32)
    return {
        "x": n(ks[0], (BATCH, SEQ, D_MODEL)),
        "c": n(ks[1], (BATCH, D_MODEL)),
        "ctx": n(ks[2], (BATCH, CTX_LEN, D_MODEL)),
        "c_ctx": n(ks[3], (D_MODEL,)),
        "norm_gain": 1.0 + 0.02 * n(ks[4], (DEPTH, D_MODEL)),
        "w_mod": 0.5 * D_MODEL ** -0.5 * n(ks[5], (DEPTH, D_MODEL, 3 * D_MODEL)),
        "b_mod": 0.02 * n(ks[6], (DEPTH, 3 * D_MODEL)),
        "w_in": D_MODEL ** -0.5 * n(ks[7], (DEPTH, D_MODEL, IN_WIDTH)),
        "att_q_gain": 1.0 + 0.02 * n(ks[8], (DEPTH, HEAD_DIM)),
        "att_k_gain": 1.0 + 0.02 * n(ks[9], (DEPTH, HEAD_DIM)),
        "pool_w": POOL_GROUP_DIM ** -0.5 * n(ks[10], (DEPTH, len(POOL_WINDOWS), POOL_GROUP_DIM, POOL_GROUP_DIM)),
        "pool_scale": 1.0 + 0.02 * n(ks[11], (DEPTH, POOL_WIDTH)),
        "na_q_gain": 1.0 + 0.02 * n(ks[12], (DEPTH, HEAD_DIM)),
        "na_k_gain": 1.0 + 0.02 * n(ks[13], (DEPTH, HEAD_DIM)),
        "na_rpb": 0.1 * n(ks[14], (DEPTH, NA_HEADS, 2 * NA_KH_MAX - 1, 2 * NA_KW - 1)),
        "w_out": MIX_WIDTH ** -0.5 * n(ks[15], (DEPTH, MIX_WIDTH, D_MODEL)),
    }


def reference(x, c, ctx, c_ctx, norm_gain, w_mod, b_mod, w_in, att_q_gain, att_k_gain,
              pool_w, pool_scale, na_q_gain, na_k_gain, na_rpb, w_out):
    bsz, seq, _ = x.shape
    n_ctx = ctx.shape[1]
    rows = seq // GRID_W
    t = jnp.arange(seq)
    row, col = t // GRID_W, t % GRID_W
    silu = jax.nn.silu
    for l in range(DEPTH):
        last = l == DEPTH - 1
        shift, scale, gate = jnp.split(silu(c) @ w_mod[l] + b_mod[l], 3, axis=-1)
        shift_c, scale_c, gate_c = jnp.split(silu(c_ctx) @ w_mod[l] + b_mod[l], 3, axis=-1)
        h = rms_norm(x, norm_gain[l]) * (1 + scale[:, None]) + shift[:, None]
        hc = rms_norm(ctx, norm_gain[l]) * (1 + scale_c) + shift_c

        aq, ak, av, ag, bz, bg, nq, nk, nv, ng = jnp.split(h @ w_in[l], SPLIT_POINTS, axis=-1)
        if last:
            ak_c, av_c = jnp.split(hc @ w_in[l][:, IN_OFFSETS[1]:IN_OFFSETS[3]], 2, axis=-1)
            nk_c, nv_c = jnp.split(hc @ w_in[l][:, IN_OFFSETS[7]:IN_OFFSETS[9]], 2, axis=-1)
        else:
            (aq_c, ak_c, av_c, ag_c, bz_c, bg_c,
             nq_c, nk_c, nv_c, ng_c) = jnp.split(hc @ w_in[l], SPLIT_POINTS, axis=-1)

        ak_c = rms_norm(ak_c.reshape(bsz, n_ctx, ATT_KV_HEADS, HEAD_DIM), att_k_gain[l])
        av_c = av_c.reshape(bsz, n_ctx, ATT_KV_HEADS, HEAD_DIM)
        nk_c = rms_norm(nk_c.reshape(bsz, n_ctx, NA_HEADS, HEAD_DIM), na_k_gain[l])
        nv_c = nv_c.reshape(bsz, n_ctx, NA_HEADS, HEAD_DIM)

        aq = rope_2d(rms_norm(aq.reshape(bsz, seq, ATT_HEADS, HEAD_DIM), att_q_gain[l]), row, col) * ATTN_SCALE
        aq = aq.reshape(bsz, seq, ATT_KV_HEADS, ATT_GROUP, HEAD_DIM)
        ak = rope_2d(rms_norm(ak.reshape(bsz, seq, ATT_KV_HEADS, HEAD_DIM), att_k_gain[l]), row, col)
        av = av.reshape(bsz, seq, ATT_KV_HEADS, HEAD_DIM)
        a_out = global_gqa(aq, ak, av, ak_c, av_c)
        b_out = pool_branch(bz, pool_w[l], pool_scale[l])
        nq = rms_norm(nq.reshape(bsz, seq, NA_HEADS, HEAD_DIM), na_q_gain[l]) * ATTN_SCALE
        nk = rms_norm(nk.reshape(bsz, seq, NA_HEADS, HEAD_DIM), na_k_gain[l])
        nv = nv.reshape(bsz, seq, NA_HEADS, HEAD_DIM)
        n_out = neighbourhood_attn(nq, nk, nv, nk_c, nv_c, na_rpb[l], rows)

        y = jnp.concatenate([a_out * silu(ag), b_out * silu(bg), n_out * silu(ng)], axis=-1) @ w_out[l]

        if not last:
            aq_c = rms_norm(aq_c.reshape(bsz, n_ctx, ATT_HEADS, HEAD_DIM), att_q_gain[l]) * ATTN_SCALE
            a_out_c = dense_attn(aq_c.reshape(bsz, n_ctx, ATT_KV_HEADS, ATT_GROUP, HEAD_DIM), ak_c, av_c)
            b_out_c = pool_branch(bz_c, pool_w[l], pool_scale[l])
            nq_c = rms_norm(nq_c.reshape(bsz, n_ctx, NA_HEADS, HEAD_DIM), na_q_gain[l]) * ATTN_SCALE
            n_out_c = dense_attn(nq_c[:, :, :, None, :], nk_c, nv_c)
            yc = jnp.concatenate([a_out_c * silu(ag_c), b_out_c * silu(bg_c), n_out_c * silu(ng_c)],
                                 axis=-1) @ w_out[l]
            ctx = ctx + gate_c * yc

        x = x + gate[:, None] * y
    return x
```

```cpp
#include <hip/hip_runtime.h>
#include <hip/hip_cooperative_groups.h>
#include <cstdio>
#include <cstdint>
namespace cg = cooperative_groups;

#define DI __device__ __forceinline__
typedef unsigned short bf16_t;
typedef short bf16x8 __attribute__((ext_vector_type(8)));
typedef float f32x16 __attribute__((ext_vector_type(16)));
typedef float f32x4 __attribute__((ext_vector_type(4)));
typedef float f32x2 __attribute__((ext_vector_type(2)));
typedef unsigned u32x4 __attribute__((ext_vector_type(4)));
typedef unsigned u32x2 __attribute__((ext_vector_type(2)));
typedef __bf16 bf2_t __attribute__((ext_vector_type(2)));

constexpr int DM = 1024, NB = 16, SEQ = 2048, NL = 4, CTX = 256, INW = 2816;
constexpr int NLAT = NB * SEQ, NCTX = NB * CTX, NTOK = NLAT + NCTX;
constexpr int KEYS = SEQ + CTX;
constexpr float LOG2E = 1.4426950408889634f;
constexpr float EPS = 1e-6f;
constexpr int LDS_BYTES = 131072 + 7680 + 16;
#ifndef NTHREADS
#define NTHREADS 512
#endif

struct Params {
  const float *x, *c, *ctx, *c_ctx, *norm_gain, *w_mod, *b_mod, *w_in, *att_q_gain, *att_k_gain, *pool_w, *pool_scale,
      *na_q_gain, *na_k_gain, *na_rpb, *w_out;
  float* out;
  bf16_t *WinT, *WoutT, *pwT, *xg, *P, *VtA, *VtN, *Y;
  float *mod, *bias, *rope, *Cbuf, *ssq;
  unsigned* bar;
};

DI int get_tid() { int t = threadIdx.x; asm volatile("" : "+v"(t)); return t; }
DI int get_bid() { int t = blockIdx.x; asm volatile("" : "+s"(t)); return t; }
DI void launder_s(int& v) { asm volatile("" : "+s"(v)); }
DI unsigned pk2(float a, float b) {
  bf2_t v = __builtin_convertvector((f32x2){a, b}, bf2_t);
  return __builtin_bit_cast(unsigned, v);
}
typedef _Float16 h2_t __attribute__((ext_vector_type(2)));
typedef _Float16 f16x8 __attribute__((ext_vector_type(8)));
DI unsigned pkh2(float a, float b) {
  h2_t v = __builtin_convertvector((f32x2){a, b}, h2_t);
  return __builtin_bit_cast(unsigned, v);
}
DI float hlo(unsigned u) { const h2_t v = __builtin_bit_cast(h2_t, u); return (float)v[0]; }
DI float hhi(unsigned u) { const h2_t v = __builtin_bit_cast(h2_t, u); return (float)v[1]; }
DI float bflo(unsigned u) { return __uint_as_float(u << 16); }
DI float bfhi(unsigned u) { return __uint_as_float(u & 0xffff0000u); }
DI f32x16 mfma32(bf16x8 a, bf16x8 b, f32x16 c) { return __builtin_amdgcn_mfma_f32_32x32x16_bf16(a, b, c, 0, 0, 0); }
DI float fast_exp2(float x) { return __builtin_amdgcn_exp2f(x); }
DI float silu_f(float v) { return v * __builtin_amdgcn_rcpf(1.f + __expf(-v)); }
DI int clampi(int v, int lo, int hi) { return v < lo ? lo : (v > hi ? hi : v); }
DI f32x16 zero16() {
  f32x16 z;
#pragma unroll
  for (int i = 0; i < 16; ++i) z[i] = 0.f;
  return z;
}

constexpr int G_BK = 64, G_HALF = 128, G_HT = G_HALF * G_BK;
DI int lds_byte(int r, int c) {
  const int st = (r >> 4) * 2 + (c >> 5), rr = r & 15, cc = c & 31, ob = rr * 64 + cc * 2;
  return st * 1024 + (ob ^ (((ob >> 9) & 1) << 5));
}
DI void stage_rc(int b, int& R, int& C) {
  const int st = b / 1024, sb = b % 1024, swz = sb ^ (((sb >> 9) & 1) << 5);
  R = (st >> 1) * 16 + swz / 64; C = (st & 1) * 32 + (swz % 64) / 2;
}
typedef __attribute__((address_space(3))) unsigned* lds_u32p;
typedef const __attribute__((address_space(1))) unsigned* glb_u32p;

template <bool F16>
DI void gemm256(const bf16_t* __restrict__ A, const bf16_t* __restrict__ Bt, int brow, int bcol, char* ldsc,
                f32x4 (&acc)[2][2][4][2]) {
  bf16_t* shm = (bf16_t*)ldsc;
  const int tid = get_tid();
  constexpr int K = DM;
#define SA(b, h) (shm + ((b) * 2 + (h)) * G_HT)
#define SB(b, h) (shm + (4 + (b) * 2 + (h)) * G_HT)
#define STAGE(P, BASE, br, kt) do { const char* _sb = (const char*)((BASE) + (long)(br) * K + (long)(kt) * G_BK); \
    _Pragma("unroll") for (int _i = 0; _i < 2; ++_i) { \
      __builtin_amdgcn_global_load_lds((glb_u32p)(_sb + (size_t)voff[_i]), \
        (lds_u32p)((char*)(P) + tid * 16 + _i * 8192), 16, 0, 0); } } while (0)
#define LDA(dst, b, h) _Pragma("unroll") for (int m = 0; m < 4; ++m) _Pragma("unroll") for (int k = 0; k < 2; ++k) \
    dst[m][k] = *reinterpret_cast<const bf16x8*>((char*)SA(b, h) + lds_byte(wr * 64 + m * 16 + fr, k * 32 + fq * 8))
#define LDB(dst, b, h) _Pragma("unroll") for (int n = 0; n < 2; ++n) _Pragma("unroll") for (int k = 0; k < 2; ++k) \
    dst[n][k] = *reinterpret_cast<const bf16x8*>((char*)SB(b, h) + lds_byte(wc * 32 + n * 16 + fr, k * 32 + fq * 8))
#define MMA(ai, bj, At, Bt_) do { __builtin_amdgcn_s_setprio(1); \
    _Pragma("unroll") for (int m = 0; m < 4; ++m) _Pragma("unroll") for (int n = 0; n < 2; ++n) _Pragma("unroll") for (int k = 0; k < 2; ++k) \
      acc[ai][bj][m][n] = F16 ? __builtin_amdgcn_mfma_f32_16x16x32_f16(__builtin_bit_cast(f16x8, At[m][k]), __builtin_bit_cast(f16x8, Bt_[n][k]), acc[ai][bj][m][n], 0, 0, 0) \
                              : __builtin_amdgcn_mfma_f32_16x16x32_bf16(At[m][k], Bt_[n][k], acc[ai][bj][m][n], 0, 0, 0); \
    __builtin_amdgcn_s_setprio(0); } while (0)
#define WAIT_V(n) asm volatile("s_waitcnt vmcnt(" #n ")" ::: "memory")
#define WAIT_L(n) asm volatile("s_waitcnt lgkmcnt(" #n ")" ::: "memory")
#define BAR __builtin_amdgcn_s_barrier()
#define SCHED __builtin_amdgcn_sched_barrier(0)
  const int wid = tid >> 6, lane = tid & 63, wr = wid >> 2, wc = wid & 3, fr = lane & 15, fq = lane >> 4;
  bf16x8 At[4][2], B0[2][2], B1[2][2];
  constexpr int nt = K / G_BK;
  unsigned voff[2];
#pragma unroll
  for (int i = 0; i < 2; ++i) { int r_, c_; stage_rc(tid * 16 + i * 8192, r_, c_); voff[i] = (unsigned)((r_ * K + c_) * 2); }
  STAGE(SB(0, 0), Bt, bcol, 0); STAGE(SB(0, 1), Bt, bcol + G_HALF, 0); STAGE(SA(0, 0), A, brow, 0); STAGE(SA(0, 1), A, brow + G_HALF, 0);
  if (wr == 1) BAR;
  WAIT_V(2); BAR;
  STAGE(SB(1, 0), Bt, bcol, 1); STAGE(SA(1, 0), A, brow, 1); STAGE(SB(1, 1), Bt, bcol + G_HALF, 1);
  WAIT_V(6); BAR;
  for (int t = 0; t < nt; t += 2) {
    const bool last = (t == nt - 2);
    const int k2 = last ? 0 : t + 2, k3 = last ? 1 : t + 3;
    LDB(B0, 0, 0); LDB(B1, 0, 1); SCHED; LDA(At, 0, 0); STAGE(SA(1, 1), A, brow + G_HALF, t + 1);
    WAIT_V(8); WAIT_L(0); BAR; MMA(0, 0, At, B0); MMA(0, 1, At, B1); BAR; SCHED;
    LDA(At, 0, 1); STAGE(SB(0, 0), Bt, bcol, k2); STAGE(SB(0, 1), Bt, bcol + G_HALF, k2); STAGE(SA(0, 0), A, brow, k2);
    WAIT_V(8); WAIT_L(0); BAR; MMA(1, 0, At, B0); MMA(1, 1, At, B1); BAR; SCHED;
    LDB(B0, 1, 0); LDB(B1, 1, 1); SCHED; LDA(At, 1, 0); STAGE(SA(0, 1), A, brow + G_HALF, k2);
    WAIT_V(8); WAIT_L(0); BAR; MMA(0, 0, At, B0); MMA(0, 1, At, B1); BAR; SCHED;
    LDA(At, 1, 1); STAGE(SB(1, 0), Bt, bcol, k3); STAGE(SB(1, 1), Bt, bcol + G_HALF, k3); STAGE(SA(1, 0), A, brow, k3);
    WAIT_V(8); WAIT_L(0); BAR; MMA(1, 0, At, B0); MMA(1, 1, At, B1); BAR; SCHED;
  }
  WAIT_V(0);
  if (wr == 0) BAR;
  BAR;
#undef SA
#undef SB
#undef STAGE
#undef LDA
#undef LDB
#undef MMA
}

typedef const __attribute__((address_space(4))) char* KCharPtr;
DI void reload_params(Params& p) {
#if defined(__HIP_DEVICE_COMPILE__)
  KCharPtr base = (KCharPtr)__builtin_amdgcn_kernarg_segment_ptr();
  asm volatile("" : "+s"(base));
  const __attribute__((address_space(4))) uint64_t* q = (const __attribute__((address_space(4))) uint64_t*)base;
  p.x = (const float*)(__attribute__((address_space(1))) const float*)q[0];
  p.c = (const float*)(__attribute__((address_space(1))) const float*)q[1];
  p.ctx = (const float*)(__attribute__((address_space(1))) const float*)q[2];
  p.c_ctx = (const float*)(__attribute__((address_space(1))) const float*)q[3];
  p.norm_gain = (const float*)(__attribute__((address_space(1))) const float*)q[4];
  p.w_mod = (const float*)(__attribute__((address_space(1))) const float*)q[5];
  p.b_mod = (const float*)(__attribute__((address_space(1))) const float*)q[6];
  p.w_in = (const float*)(__attribute__((address_space(1))) const float*)q[7];
  p.att_q_gain = (const float*)(__attribute__((address_space(1))) const float*)q[8];
  p.att_k_gain = (const float*)(__attribute__((address_space(1))) const float*)q[9];
  p.pool_w = (const float*)(__attribute__((address_space(1))) const float*)q[10];
  p.pool_scale = (const float*)(__attribute__((address_space(1))) const float*)q[11];
  p.na_q_gain = (const float*)(__attribute__((address_space(1))) const float*)q[12];
  p.na_k_gain = (const float*)(__attribute__((address_space(1))) const float*)q[13];
  p.na_rpb = (const float*)(__attribute__((address_space(1))) const float*)q[14];
  p.w_out = (const float*)(__attribute__((address_space(1))) const float*)q[15];
  p.out = (float*)(__attribute__((address_space(1))) float*)q[16];
  p.WinT = (bf16_t*)(__attribute__((address_space(1))) bf16_t*)q[17];
  p.WoutT = (bf16_t*)(__attribute__((address_space(1))) bf16_t*)q[18];
  p.pwT = (bf16_t*)(__attribute__((address_space(1))) bf16_t*)q[19];
  p.xg = (bf16_t*)(__attribute__((address_space(1))) bf16_t*)q[20];
  p.P = (bf16_t*)(__attribute__((address_space(1))) bf16_t*)q[21];
  p.VtA = (bf16_t*)(__attribute__((address_space(1))) bf16_t*)q[22];
  p.VtN = (bf16_t*)(__attribute__((address_space(1))) bf16_t*)q[23];
  p.Y = (bf16_t*)(__attribute__((address_space(1))) bf16_t*)q[24];
  p.mod = (float*)(__attribute__((address_space(1))) float*)q[25];
  p.bias = (float*)(__attribute__((address_space(1))) float*)q[26];
  p.rope = (float*)(__attribute__((address_space(1))) float*)q[27];
  p.Cbuf = (float*)(__attribute__((address_space(1))) float*)q[28];
  p.ssq = (float*)(__attribute__((address_space(1))) float*)q[29];
  p.bar = (unsigned*)(__attribute__((address_space(1))) unsigned*)q[30];
#else
  (void)p;
#endif
}

DI void zero_acc(f32x4 (&acc)[2][2][4][2]) {
#pragma unroll
  for (int a = 0; a < 2; ++a)
#pragma unroll
    for (int b = 0; b < 2; ++b)
#pragma unroll
      for (int m = 0; m < 4; ++m)
#pragma unroll
        for (int n = 0; n < 2; ++n) acc[a][b][m][n] = (f32x4){0.f, 0.f, 0.f, 0.f};
}

DI void phaseA_tile(const Params& p0, int l, int ft, int mt, char* lds) {
  f32x4 acc[2][2][4][2];
  zero_acc(acc);
  gemm256<true>(p0.WinT + (size_t)l * INW * DM, p0.xg, ft * 256, mt * 256, lds, acc);
  launder_s(l); launder_s(ft); launder_s(mt);
  Params p; reload_params(p);
  const int n0 = ft * 256, m0 = mt * 256;
  const int tid = get_tid(), lane = tid & 63, wid = tid >> 6, wr = wid >> 2, wc = wid & 3, fr = lane & 15, fq = lane >> 4;

  const bool is_ctx = m0 >= NLAT;
  int b, s_base, modrow;
  if (!is_ctx) { b = m0 / SEQ; s_base = m0 % SEQ; modrow = b; }
  else { const int c = m0 - NLAT; b = c / CTX; s_base = c % CTX; modrow = 16; }
  int tl[4];
#pragma unroll
  for (int g = 0; g < 4; ++g) tl[g] = (g >> 1) * 128 + wc * 32 + (g & 1) * 16 + fr;
  float rstd[4];
#pragma unroll
  for (int gp = 0; gp < 2; ++gp) {
    f32x4 sq[2][4];
#pragma unroll
    for (int n = 0; n < 2; ++n) {
      const f32x4* sp = (const f32x4*)(p.ssq + (size_t)(m0 + tl[gp * 2 + n]) * 16);
#pragma unroll
      for (int q = 0; q < 4; ++q) sq[n][q] = sp[q];
    }
#pragma unroll
    for (int n = 0; n < 2; ++n) {
      float ss = 0.f;
#pragma unroll
      for (int q = 0; q < 4; ++q) ss += (sq[n][q][0] + sq[n][q][1]) + (sq[n][q][2] + sq[n][q][3]);
      rstd[gp * 2 + n] = rsqrtf(ss * (1.f / DM) + EPS);
    }
  }
#pragma unroll
  for (int ai = 0; ai < 2; ++ai) {
    const int f0 = n0 + ai * 128 + wr * 64;
    const int hd = f0 >> 6;
    int kind = 0; const float* gain = p.att_q_gain; bool do_rope = false; bool do_scale = false;
    bf16_t* vtb = nullptr;
    if (hd < 8) { kind = 2; gain = p.att_q_gain + l * 64; do_rope = !is_ctx; do_scale = true; }
    else if (hd < 10) { kind = 2; gain = p.att_k_gain + l * 64; do_rope = !is_ctx; }
    else if (hd < 12) { kind = 3; vtb = p.VtA + (size_t)((b * 2 + (hd - 10)) * 64) * KEYS; }
    else if (hd < 20) { kind = 1; }
    else if (hd < 24) { kind = 0; }
    else if (hd < 28) { kind = 1; }
    else if (hd < 32) { kind = 2; gain = p.na_q_gain + l * 64; do_scale = true; }
    else if (hd < 36) { kind = 2; gain = p.na_k_gain + l * 64; }
    else if (hd < 40) { kind = 3; vtb = p.VtN + (size_t)((b * 4 + (hd - 36)) * 64) * KEYS; }
    else { kind = 1; }
    const float* biasp = p.bias + (size_t)(l * 17 + modrow) * INW + f0 + fq * 4;
    f32x4 bv[4];
#pragma unroll
    for (int m = 0; m < 4; ++m) bv[m] = *(const f32x4*)(biasp + m * 16);
    const float sc = do_scale ? 0.125f * LOG2E : 1.f;
#pragma unroll
    for (int gp = 0; gp < 2; ++gp) {
      float v[2][4][4];
#pragma unroll
      for (int n = 0; n < 2; ++n)
#pragma unroll
        for (int m = 0; m < 4; ++m)
#pragma unroll
          for (int j = 0; j < 4; ++j) v[n][m][j] = acc[ai][gp][m][n][j] * rstd[gp * 2 + n] + bv[m][j];
      if (kind == 1) {
#pragma unroll
        for (int n = 0; n < 2; ++n)
#pragma unroll
          for (int m = 0; m < 4; ++m)
#pragma unroll
            for (int j = 0; j < 4; ++j) v[n][m][j] = silu_f(v[n][m][j]);
      } else if (kind == 2) {
        f32x4 gv[4];
#pragma unroll
        for (int m = 0; m < 4; ++m) gv[m] = *(const f32x4*)(gain + m * 16 + fq * 4);
#pragma unroll
        for (int n = 0; n < 2; ++n) {
          float ss = 0.f;
#pragma unroll
          for (int m = 0; m < 4; ++m)
#pragma unroll
            for (int j = 0; j < 4; ++j) ss += v[n][m][j] * v[n][m][j];
          ss += __shfl_xor(ss, 16);
          ss += __shfl_xor(ss, 32);
          const float rn = rsqrtf(ss * (1.f / 64.f) + EPS) * sc;
#pragma unroll
          for (int m = 0; m < 4; ++m)
#pragma unroll
            for (int j = 0; j < 4; ++j) v[n][m][j] *= rn * gv[m][j];
        }
        if (do_rope) {
#pragma unroll
          for (int n = 0; n < 2; ++n) {
            f32x4 cs4[2][2];
            const int s = s_base + tl[gp * 2 + n];
#pragma unroll
            for (int hf = 0; hf < 2; ++hf) {
              const int pos = hf == 0 ? (s >> 6) : (s & 63);
              const float* tb = p.rope + (size_t)pos * 32 + fq * 8;
              cs4[hf][0] = *(const f32x4*)(tb);
              cs4[hf][1] = *(const f32x4*)(tb + 4);
            }
#pragma unroll
            for (int hf = 0; hf < 2; ++hf)
#pragma unroll
              for (int j = 0; j < 4; ++j) {
                const float c = cs4[hf][j >> 1][(j & 1) * 2], sn = cs4[hf][j >> 1][(j & 1) * 2 + 1];
                const float x1 = v[n][2 * hf][j], x2 = v[n][2 * hf + 1][j];
                v[n][2 * hf][j] = x1 * c - x2 * sn;
                v[n][2 * hf + 1][j] = x2 * c + x1 * sn;
              }
          }
        }
      }
      if (kind == 3) {
#pragma unroll
        for (int n = 0; n < 2; ++n) {
          const int kraw = (is_ctx ? SEQ : 0) + s_base + tl[gp * 2 + n];
          const int k16 = kraw & 15;
          const int kidx = (kraw & ~15) | ((k16 & 3) | ((k16 & 4) << 1) | ((k16 & 8) >> 1));
#pragma unroll
          for (int m = 0; m < 4; ++m)
#pragma unroll
            for (int j = 0; j < 4; ++j) {
              const int d = m * 16 + fq * 4 + j;
              const unsigned u = pk2(v[n][m][j], 0.f);
              vtb[(size_t)d * KEYS + kidx] = (bf16_t)(u & 0xffffu);
            }
        }
      } else {
#pragma unroll
        for (int n = 0; n < 2; ++n) {
          const int tlv = tl[gp * 2 + n];
#pragma unroll
          for (int m = 0; m < 4; ++m) {
            u32x2 o;
            o[0] = pk2(v[n][m][0], v[n][m][1]);
            o[1] = pk2(v[n][m][2], v[n][m][3]);
            const int fl = ai * 128 + wr * 64 + m * 16 + fq * 4;
            *(u32x2*)(lds + tlv * 512 + (((fl >> 3) ^ (tlv & 31)) << 4) + ((fl >> 2) & 1) * 8) = o;
          }
        }
      }
    }
  }
  __syncthreads();
  if (ft != 9) {
    const int nch = (ft == 2) ? 16 : 32;
#pragma unroll 4
    for (int i = 0; i < 16; ++i) {
      const int idx = tid + NTHREADS * i;
      const int row = idx >> 5, c = idx & 31;
      if (c < nch) {
        const u32x4 val = *(const u32x4*)(lds + row * 512 + ((c ^ (row & 31)) << 4));
        *(u32x4*)(p.P + (size_t)(m0 + row) * INW + n0 + c * 8) = val;
      }
    }
  }
  __syncthreads();
}

template <bool HN, bool L0>
DI void phaseC_epi(const Params& p, f32x4 (&acc)[2][2][4][2], int l, int n0, int m0) {
  const int tid = get_tid(), lane = tid & 63, wid = tid >> 6, wr = wid >> 2, wc = wid & 3, fr = lane & 15, fq = lane >> 4;
  const bool is_ctx = m0 >= NLAT;
  const int modrow = is_ctx ? 16 : (m0 / SEQ);
  const float* xin0 = is_ctx ? p.ctx : p.x;
  const int rowoff = is_ctx ? NLAT : 0;
  int tok[4];
#pragma unroll
  for (int g = 0; g < 4; ++g) tok[g] = m0 + (g >> 1) * 128 + wc * 32 + (g & 1) * 16 + fr;
#pragma unroll
  for (int ai = 0; ai < 2; ++ai) {
    const int f0 = n0 + ai * 128 + wr * 64 + fq * 4;
    const float* gatep = p.mod + (size_t)(l * 17 + modrow) * 3072 + 2048 + f0;
    {
      f32x4 gt[4];
#pragma unroll
      for (int m = 0; m < 4; ++m) gt[m] = *(const f32x4*)(gatep + m * 16);
#pragma unroll
      for (int g = 0; g < 4; ++g)
#pragma unroll
        for (int m = 0; m < 4; ++m)
#pragma unroll
          for (int j = 0; j < 4; ++j) acc[ai][g >> 1][m][g & 1][j] *= gt[m][j];
    }
    __builtin_amdgcn_sched_barrier(0);
    f32x4 gs[4], rgs[4];
#pragma unroll
    for (int m = 0; m < 4; ++m) {
      if (!L0) {
        const f32x4 g0 = *(const f32x4*)(p.norm_gain + (size_t)l * DM + f0 + m * 16);
        const f32x4 s0 = *(const f32x4*)(p.mod + (size_t)(l * 17 + modrow) * 3072 + 1024 + f0 + m * 16);
#pragma unroll
        for (int j = 0; j < 4; ++j) rgs[m][j] = __builtin_amdgcn_rcpf(g0[j] * (1.f + s0[j]));
      }
      if (HN) {
        const f32x4 g1 = *(const f32x4*)(p.norm_gain + (size_t)(l + 1) * DM + f0 + m * 16);
        const f32x4 s1 = *(const f32x4*)(p.mod + (size_t)((l + 1) * 17 + modrow) * 3072 + 1024 + f0 + m * 16);
#pragma unroll
        for (int j = 0; j < 4; ++j) gs[m][j] = g1[j] * (1.f + s1[j]);
      }
    }
#pragma unroll
    for (int gp = 0; gp < 2; ++gp) {
      f32x4 xv[2][4];
      u32x2 xb[2][4];
#pragma unroll
      for (int n = 0; n < 2; ++n)
#pragma unroll
        for (int m = 0; m < 4; ++m) {
          if (L0) xv[n][m] = *(const f32x4*)(xin0 + (size_t)(tok[gp * 2 + n] - rowoff) * DM + f0 + m * 16);
          else xb[n][m] = *(const u32x2*)(p.xg + (size_t)tok[gp * 2 + n] * DM + f0 + m * 16);
        }
#pragma unroll
      for (int n = 0; n < 2; ++n) {
        const int g = gp * 2 + n;
        float ss = 0.f;
#pragma unroll
        for (int m = 0; m < 4; ++m) {
          f32x4 xx;
          if (L0) xx = xv[n][m];
          else {
            xx[0] = hlo(xb[n][m][0]) * rgs[m][0]; xx[1] = hhi(xb[n][m][0]) * rgs[m][1];
            xx[2] = hlo(xb[n][m][1]) * rgs[m][2]; xx[3] = hhi(xb[n][m][1]) * rgs[m][3];
          }
          f32x4 nv;
#pragma unroll
          for (int j = 0; j < 4; ++j) { nv[j] = xx[j] + acc[ai][gp][m][n][j]; ss += nv[j] * nv[j]; }
          if (HN) {
            u32x2 o;
            o[0] = pkh2(nv[0] * gs[m][0], nv[1] * gs[m][1]);
            o[1] = pkh2(nv[2] * gs[m][2], nv[3] * gs[m][3]);
            *(u32x2*)(p.xg + (size_t)tok[g] * DM + f0 + m * 16) = o;
          } else {
            *(f32x4*)(p.out + (size_t)tok[g] * DM + f0 + m * 16) = nv;
          }
        }
        if (HN) {
          ss += __shfl_xor(ss, 16);
          ss += __shfl_xor(ss, 32);
          if (fq == 0) p.ssq[(size_t)tok[g] * 16 + (n0 >> 6) + ai * 2 + wr] = ss;
        }
      }
    }
  }
}

DI void phaseC_tile(const Params& p0, int l, int ft, int mt, char* lds) {
  f32x4 acc[2][2][4][2];
  zero_acc(acc);
  gemm256<false>(p0.WoutT + (size_t)l * DM * DM, p0.Y, ft * 256, mt * 256, lds, acc);
  launder_s(l); launder_s(ft); launder_s(mt);
  Params p; reload_params(p);
  if (l + 1 < NL) phaseC_epi<true, false>(p, acc, l, ft * 256, mt * 256);
  else phaseC_epi<false, false>(p, acc, l, ft * 256, mt * 256);
}

template <bool NA, bool TRACK>
DI void attn_item(char* lds, const bf16_t* P, bf16_t* Y, const bf16_t* vt, int rp, int q_off, int k1_off, int nt1,
                  int vk1, int k2_off, int nt2, int vk2, int g_off, int y_off, int rlo, const float* rpb) {
  asm volatile("" : "+v"(q_off), "+v"(g_off), "+v"(y_off));
  const bf16_t* qp = P + q_off;
  const bf16_t* kp1 = P + k1_off;
  const bf16_t* kp2 = P + k2_off;
  const int tid = get_tid(), lane = tid & 63, w = tid >> 6, r = lane & 31, h = lane >> 5;
  const int lr = tid >> 3, lc = tid & 7;
  const int nt = nt1 + nt2;
  const int woff = lr * 128 + ((lc ^ ((lr >> 1) & 7)) << 4);
  const int swz = (r >> 1) & 7;
  float* tab = (float*)(lds + 131072);
  int rw = 0, r0w = 0, cq = 0, c0 = 0;
  if (NA) {
    rw = rp * 4 + (w >> 1);
    r0w = clampi(rw - 4, 0, 24);
    cq = (w & 1) * 32 + r;
    c0 = clampi(cq - 8, 0, 48);
    for (int e = tid; e < 15 * 128; e += NTHREADS) {
      const int dr = e >> 7, dc = (e & 127) - 48;
      tab[e] = (dc >= 0 && dc < 31) ? rpb[dr * 31 + dc] * LOG2E : 0.f;
    }
  }
  bf16x8 qf[4];
#pragma unroll
  for (int ks = 0; ks < 4; ++ks) qf[ks] = *(const bf16x8*)(qp + (size_t)(w * 32 + r) * INW + ks * 16 + h * 8);
  u32x2 gate[2][4];
#pragma unroll
  for (int dm = 0; dm < 2; ++dm)
#pragma unroll
    for (int g = 0; g < 4; ++g)
      gate[dm][g] = *(const u32x2*)(P + g_off + (size_t)(w * 32 + r) * INW + dm * 32 + 8 * g + 4 * h);
#pragma unroll
  for (int ks = 0; ks < 4; ++ks) asm volatile("" : "+v"(qf[ks]));
#pragma unroll
  for (int dm = 0; dm < 2; ++dm)
#pragma unroll
    for (int g = 0; g < 4; ++g) asm volatile("" : "+v"(gate[dm][g]));
  f32x16 o[2];
  o[0] = zero16(); o[1] = zero16();
  f32x16 negm;
#pragma unroll
  for (int i = 0; i < 16; ++i) negm[i] = 0.f;
  float l_run = 0.f;

  constexpr int TPI = 4;
  const int niter = (nt + TPI - 1) / TPI;
  u32x4 rk[TPI], rv[TPI];
#define ATT_LOAD(IT) do { _Pragma("unroll") for (int j_ = 0; j_ < TPI; ++j_) { const int t_ = (IT) * TPI + j_; if (t_ < nt) { \
      const bf16_t* kp_; int vk_; \
      if (t_ < nt1) { kp_ = kp1 + (size_t)t_ * 64 * INW; vk_ = vk1 + t_ * 64; } \
      else { kp_ = kp2 + (size_t)(t_ - nt1) * 64 * INW; vk_ = vk2 + (t_ - nt1) * 64; } \
      rk[j_] = *(const u32x4*)(kp_ + (size_t)lr * INW + lc * 8); \
      rv[j_] = *(const u32x4*)(vt + (size_t)lr * KEYS + vk_ + lc * 8); } } } while (0)
#define ATT_WRITE(IT, HALF) do { _Pragma("unroll") for (int j_ = 0; j_ < TPI; ++j_) { const int t_ = (IT) * TPI + j_; if (t_ < nt) { \
      char* sl_ = lds + (HALF) * 65536 + j_ * 16384; \
      *(u32x4*)(sl_ + woff) = rk[j_]; \
      *(u32x4*)(sl_ + 8192 + woff) = rv[j_]; } } } while (0)
  ATT_LOAD(0);
  ATT_WRITE(0, 0);
  __syncthreads();
  for (int it = 0; it < niter; ++it) {
    const int hb = it & 1;
    if constexpr (NA || TRACK) { if (it + 1 < niter) ATT_LOAD(it + 1); }
    if constexpr (!NA && !TRACK) {
#define ATT_LOAD2(IT, H) do { _Pragma("unroll") for (int j_ = 0; j_ < 2; ++j_) { const int t_ = (IT) * TPI + 2 * (H) + j_; \
      const bf16_t* kp_; int vk_; \
      if (t_ < nt1) { kp_ = kp1 + (size_t)t_ * 64 * INW; vk_ = vk1 + t_ * 64; } \
      else { kp_ = kp2 + (size_t)(t_ - nt1) * 64 * INW; vk_ = vk2 + (t_ - nt1) * 64; } \
      rk[j_] = *(const u32x4*)(kp_ + (size_t)lr * INW + lc * 8); \
      rv[j_] = *(const u32x4*)(vt + (size_t)lr * KEYS + vk_ + lc * 8); } } while (0)
#define ATT_WRITE2(HALF, H) do { _Pragma("unroll") for (int j_ = 0; j_ < 2; ++j_) { \
      char* sl_ = lds + (HALF) * 65536 + (2 * (H) + j_) * 16384; \
      *(u32x4*)(sl_ + woff) = rk[j_]; \
      *(u32x4*)(sl_ + 8192 + woff) = rv[j_]; } } while (0)
      const bool more = it + 1 < niter;
      if (more) ATT_LOAD2(it + 1, 0);
      const char* Kb = lds + hb * 65536;
      f32x16 sc[2], sn[2];
#define ATT_QK(S, J) do { const char* Kp_ = Kb + (J) * 16384; bf16x8 kf_[8]; \
        _Pragma("unroll") for (int kt_ = 0; kt_ < 2; ++kt_) _Pragma("unroll") for (int ks_ = 0; ks_ < 4; ++ks_) \
          kf_[kt_ * 4 + ks_] = *(const bf16x8*)(Kp_ + (kt_ * 32 + r) * 128 + (((2 * ks_ + h) ^ swz) << 4)); \
        _Pragma("unroll") for (int kt_ = 0; kt_ < 2; ++kt_) { \
          S[kt_] = mfma32(kf_[kt_ * 4], qf[0], zero16()); \
          _Pragma("unroll") for (int ks_ = 1; ks_ < 4; ++ks_) S[kt_] = mfma32(kf_[kt_ * 4 + ks_], qf[ks_], S[kt_]); } } while (0)
      ATT_QK(sc, 0);
#pragma unroll
      for (int j = 0; j < TPI; ++j) {
        const char* Vs = Kb + j * 16384 + 8192;
        if (j + 1 < TPI) ATT_QK(sn, j + 1);
        float ps = 0.f;
#pragma unroll
        for (int kt = 0; kt < 2; ++kt) {
          bf16x8 vf[4];
#pragma unroll
          for (int sp = 0; sp < 2; ++sp)
#pragma unroll
            for (int dm = 0; dm < 2; ++dm)
              vf[sp * 2 + dm] = *(const bf16x8*)(Vs + (dm * 32 + r) * 128 + (((4 * kt + 2 * sp + h) ^ swz) << 4));
#pragma unroll
          for (int i = 0; i < 16; ++i) {
            const float pv = fast_exp2(sc[kt][i]);
            ps += pv;
            sc[kt][i] = pv;
          }
#pragma unroll
          for (int sp = 0; sp < 2; ++sp) {
            u32x4 pu;
            pu[0] = pk2(sc[kt][8 * sp + 0], sc[kt][8 * sp + 1]);
            pu[1] = pk2(sc[kt][8 * sp + 2], sc[kt][8 * sp + 3]);
            pu[2] = pk2(sc[kt][8 * sp + 4], sc[kt][8 * sp + 5]);
            pu[3] = pk2(sc[kt][8 * sp + 6], sc[kt][8 * sp + 7]);
            const bf16x8 pf = __builtin_bit_cast(bf16x8, pu);
#pragma unroll
            for (int dm = 0; dm < 2; ++dm) o[dm] = mfma32(vf[sp * 2 + dm], pf, o[dm]);
          }
        }
        l_run += ps;
        if (j + 1 < TPI) { sc[0] = sn[0]; sc[1] = sn[1]; }
        if (j == 1 && more) { ATT_WRITE2(hb ^ 1, 0); ATT_LOAD2(it + 1, 1); }
      }
      if (more) ATT_WRITE2(hb ^ 1, 1);
#undef ATT_QK
#undef ATT_LOAD2
#undef ATT_WRITE2
    } else
#pragma unroll 1
    for (int j = 0; j < TPI; ++j) {
      const int t = it * TPI + j;
      if (t >= nt) break;
      bool active = true;
      int drow = 0;
      if (NA && t < nt1) {
        const int R = rlo + t;
        active = (R >= r0w) && (R < r0w + 8);
        drow = R - rw + 7;
      }
      if (active) {
        const char* Ks = lds + hb * 65536 + j * 16384;
        const char* Vs = Ks + 8192;
        bf16x8 kf[8];
#pragma unroll
        for (int kt = 0; kt < 2; ++kt)
#pragma unroll
          for (int ks = 0; ks < 4; ++ks)
            kf[kt * 4 + ks] = *(const bf16x8*)(Ks + (kt * 32 + r) * 128 + (((2 * ks + h) ^ swz) << 4));
        __builtin_amdgcn_sched_barrier(0);
        f32x16 s[2];
        __builtin_amdgcn_s_setprio(1);
#pragma unroll
        for (int kt = 0; kt < 2; ++kt) {
          s[kt] = mfma32(kf[kt * 4], qf[0], negm);
#pragma unroll
          for (int ks = 1; ks < 4; ++ks) s[kt] = mfma32(kf[kt * 4 + ks], qf[ks], s[kt]);
        }
        __builtin_amdgcn_s_setprio(0);
        bf16x8 vf[8];
#pragma unroll
        for (int kt = 0; kt < 2; ++kt)
#pragma unroll
          for (int sp = 0; sp < 2; ++sp)
#pragma unroll
            for (int dm = 0; dm < 2; ++dm)
              vf[(kt * 2 + sp) * 2 + dm] = *(const bf16x8*)(Vs + (dm * 32 + r) * 128 + (((4 * kt + 2 * sp + h) ^ swz) << 4));
        __builtin_amdgcn_sched_barrier(0);
        if (NA) {
          if (t < nt1) {
            const float* trow = tab + drow * 128 + 63 - cq;
#pragma unroll
            for (int kt = 0; kt < 2; ++kt)
#pragma unroll
              for (int i = 0; i < 16; ++i) {
                const int kc = kt * 32 + (i & 3) + 8 * (i >> 2) + 4 * h;
                const bool ok = (unsigned)(kc - c0) < 16u;
                const float t2 = s[kt][i] + trow[kc];
                s[kt][i] = ok ? t2 : -1e30f;
              }
          }
        }
        float mx = 0.f;
        if (TRACK) {
          mx = fmaxf(s[0][0], s[1][0]);
#pragma unroll
          for (int i = 1; i < 16; ++i) mx = fmaxf(fmaxf(mx, s[0][i]), s[1][i]);
          mx = fmaxf(mx, __shfl_xor(mx, 32));
        }
        if (TRACK && __any(mx > 8.f)) {
          const float dlt = fmaxf(mx, 0.f);
          const float alpha = fast_exp2(-dlt);
          l_run *= alpha;
#pragma unroll
          for (int i = 0; i < 16; ++i) { o[0][i] *= alpha; o[1][i] *= alpha; negm[i] -= dlt; }
#pragma unroll
          for (int i = 0; i < 16; ++i) { s[0][i] -= dlt; s[1][i] -= dlt; }
        }
        float ps = 0.f;
#pragma unroll
        for (int kt = 0; kt < 2; ++kt)
#pragma unroll
          for (int i = 0; i < 16; ++i) {
            const float pv = fast_exp2(s[kt][i]);
            ps += pv;
            s[kt][i] = pv;
          }
        l_run += ps;
#pragma unroll
        for (int kt = 0; kt < 2; ++kt)
#pragma unroll
          for (int sp = 0; sp < 2; ++sp) {
            u32x4 pu;
            pu[0] = pk2(s[kt][8 * sp + 0], s[kt][8 * sp + 1]);
            pu[1] = pk2(s[kt][8 * sp + 2], s[kt][8 * sp + 3]);
            pu[2] = pk2(s[kt][8 * sp + 4], s[kt][8 * sp + 5]);
            pu[3] = pk2(s[kt][8 * sp + 6], s[kt][8 * sp + 7]);
            const bf16x8 pf = __builtin_bit_cast(bf16x8, pu);
#pragma unroll
            for (int dm = 0; dm < 2; ++dm) o[dm] = mfma32(vf[(kt * 2 + sp) * 2 + dm], pf, o[dm]);
          }
      }
    }
    if constexpr (NA || TRACK) { if (it + 1 < niter) ATT_WRITE(it + 1, hb ^ 1); }
    __syncthreads();
  }
#undef ATT_LOAD
#undef ATT_WRITE
  const float lt = l_run + __shfl_xor(l_run, 32);
  const float inv = 1.f / lt;
  int row = w * 32 + r;
  asm volatile("" : "+v"(row));
  bf16_t* yp = Y + y_off;
#pragma unroll
  for (int dm = 0; dm < 2; ++dm) {
    u32x2 ov[4];
#pragma unroll
    for (int g = 0; g < 4; ++g) {
      const u32x2 gv = gate[dm][g];
      ov[g][0] = pk2(o[dm][4 * g + 0] * inv * bflo(gv[0]), o[dm][4 * g + 1] * inv * bfhi(gv[0]));
      ov[g][1] = pk2(o[dm][4 * g + 2] * inv * bflo(gv[1]), o[dm][4 * g + 3] * inv * bfhi(gv[1]));
    }
#pragma unroll
    for (int a = 0; a < 2; ++a) {
      const int ga = 2 * a, gb = 2 * a + 1;
      const unsigned s0 = h ? ov[ga][0] : ov[gb][0], s1 = h ? ov[ga][1] : ov[gb][1];
      const unsigned r0 = (unsigned)__shfl_xor((int)s0, 32), r1 = (unsigned)__shfl_xor((int)s1, 32);
      u32x4 wv;
      wv[0] = h ? r0 : ov[ga][0];
      wv[1] = h ? r1 : ov[ga][1];
      wv[2] = h ? ov[gb][0] : r0;
      wv[3] = h ? ov[gb][1] : r1;
      *(u32x4*)(yp + (size_t)row * DM + dm * 32 + 8 * (ga + h)) = wv;
    }
  }
}

DI void pool_item(const Params& p, int l, int token0, char* lds) {
  const int tid = get_tid(), lane = tid & 63, w = tid >> 6, r = lane & 31, h = lane >> 5;
  int seqbase, L;
  if (token0 < NLAT) { seqbase = (token0 / SEQ) * SEQ; L = SEQ; }
  else { seqbase = NLAT + ((token0 - NLAT) / CTX) * CTX; L = CTX; }
  const int s0 = token0 - seqbase;
  char* zt = lds;
  char* pl = lds + 40960;
  f32x4 scp[2][4];
  u32x2 gvp[2][4];
  {
    const int g_ = w & 3, tok_ = token0 + (w >> 2) * 32 + r;
#pragma unroll
    for (int mo = 0; mo < 2; ++mo)
#pragma unroll
      for (int gg = 0; gg < 4; ++gg) {
        const int oc = mo * 32 + 8 * gg + 4 * h;
        scp[mo][gg] = *(const f32x4*)(p.pool_scale + l * 256 + g_ * 64 + oc);
        gvp[mo][gg] = *(const u32x2*)(p.P + (size_t)tok_ * INW + 1536 + g_ * 64 + oc);
      }
  }
  bf16x8 wfp[2][4];
  {
    const bf16_t* wp_ = p.pwT + (size_t)((l * 4 + (w & 3)) * 64) * 64;
#pragma unroll
    for (int mo = 0; mo < 2; ++mo)
#pragma unroll
      for (int ks = 0; ks < 4; ++ks) wfp[mo][ks] = *(const bf16x8*)(wp_ + (size_t)(mo * 32 + r) * 64 + ks * 16 + h * 8);
  }
  for (int e = tid; e < 80 * 32; e += NTHREADS) {
    const int row = e >> 5, ch = e & 31;
    const int s = s0 - 8 + row;
    u32x4 v = {0u, 0u, 0u, 0u};
    if (s >= 0 && s < L) v = *(const u32x4*)(p.P + (size_t)(seqbase + s) * INW + 1280 + ch * 8);
    *(u32x4*)(zt + row * 512 + ch * 16) = v;
  }
  __syncthreads();
  for (int e = tid; e < 64 * 32; e += NTHREADS) {
    const int tl = e >> 5, ch = e & 31;
    const int g = ch >> 3;
    const int hw = 1 << g;
    const int s = s0 + tl;
    int lo = s - hw; lo = lo < 0 ? 0 : lo;
    int hi = s + hw - 1; hi = hi > L - 1 ? L - 1 : hi;
    float sum[8];
#pragma unroll
    for (int j = 0; j < 8; ++j) sum[j] = 0.f;
    for (int q = lo; q <= hi; ++q) {
      const u32x4 v = *(const u32x4*)(zt + (q - s0 + 8) * 512 + ch * 16);
#pragma unroll
      for (int j = 0; j < 4; ++j) { sum[2 * j] += bflo(v[j]); sum[2 * j + 1] += bfhi(v[j]); }
    }
    const float ic = 1.f / (float)(hi - lo + 1);
    const u32x4 zc = *(const u32x4*)(zt + (tl + 8) * 512 + ch * 16);
    u32x4 ov;
#pragma unroll
    for (int j = 0; j < 4; ++j)
      ov[j] = pk2(sum[2 * j] * ic - bflo(zc[j]), sum[2 * j + 1] * ic - bfhi(zc[j]));
    *(u32x4*)(pl + tl * 512 + ((ch ^ (tl & 15)) << 4)) = ov;
  }
  __syncthreads();
  {
    const int g = w & 3, tn0 = w >> 2;
    f32x16 acc[2][2];
#pragma unroll
    for (int a = 0; a < 2; ++a)
#pragma unroll
      for (int b = 0; b < 2; ++b) acc[a][b] = zero16();
#pragma unroll
    for (int ks = 0; ks < 4; ++ks) {
      bf16x8 a[2], b[2];
#pragma unroll
      for (int mo = 0; mo < 2; ++mo) a[mo] = wfp[mo][ks];
      {
        const int row = tn0 * 32 + r;
        const int ch = g * 8 + 2 * ks + h;
        b[0] = *(const bf16x8*)(pl + row * 512 + ((ch ^ (row & 15)) << 4));
      }
#pragma unroll
      for (int mo = 0; mo < 2; ++mo) acc[mo][0] = mfma32(a[mo], b[0], acc[mo][0]);
    }
    {
      const int tn = 0;
      const int token = token0 + tn0 * 32 + r;
#pragma unroll
      for (int mo = 0; mo < 2; ++mo)
#pragma unroll
        for (int gg = 0; gg < 4; ++gg) {
          const int oc = mo * 32 + 8 * gg + 4 * h;
          const f32x4 sc = scp[mo][gg];
          const u32x2 gv = gvp[mo][gg];
          u32x2 ov;
          ov[0] = pk2(acc[mo][tn][4 * gg + 0] * sc[0] * bflo(gv[0]), acc[mo][tn][4 * gg + 1] * sc[1] * bfhi(gv[0]));
          ov[1] = pk2(acc[mo][tn][4 * gg + 2] * sc[2] * bflo(gv[1]), acc[mo][tn][4 * gg + 3] * sc[3] * bfhi(gv[1]));
          *(u32x2*)(p.Y + (size_t)token * DM + 512 + g * 64 + oc) = ov;
        }
    }
  }
  __syncthreads();
}

DI void gemv17(const float* in16, int istride, const float* in1, bool do_silu, const float* W, int ldw, int n0,
               const float* bvec, float* out, int ostride, char* lds) {
  const int tid = get_tid(), col = tid & 63, kp = tid >> 6;
  float* sc = (float*)lds;
  float* red = (float*)(lds + 34816);
  float acc[17];
#pragma unroll
  for (int j = 0; j < 17; ++j) acc[j] = 0.f;
  for (int kh = 0; kh < 2; ++kh) {
    __syncthreads();
    for (int e = tid; e < 17 * 512; e += NTHREADS) {
      const int j = e >> 9, k = e & 511;
      float v = (j < 16) ? in16[(size_t)j * istride + kh * 512 + k] : in1[kh * 512 + k];
      if (do_silu) v = v / (1.f + expf(-v));
      sc[e] = v;
    }
    __syncthreads();
    const float* wp = W + (size_t)(kh * 512 + kp * 64) * ldw + n0 + col;
#pragma unroll 16
    for (int kk = 0; kk < 64; ++kk) {
      const float wv = wp[(size_t)kk * ldw];
      const float* sp = sc + kp * 64 + kk;
#pragma unroll
      for (int j = 0; j < 17; ++j) acc[j] += sp[j * 512] * wv;
    }
  }
#pragma unroll
  for (int j = 0; j < 17; ++j) red[(kp * 17 + j) * 64 + col] = acc[j];
  __syncthreads();
  for (int e = tid; e < 17 * 64; e += NTHREADS) {
    const int j = e >> 6, cc = e & 63;
    float v = ((red[(0 * 17 + j) * 64 + cc] + red[(1 * 17 + j) * 64 + cc]) +
               (red[(2 * 17 + j) * 64 + cc] + red[(3 * 17 + j) * 64 + cc])) +
              ((red[(4 * 17 + j) * 64 + cc] + red[(5 * 17 + j) * 64 + cc]) +
               (red[(6 * 17 + j) * 64 + cc] + red[(7 * 17 + j) * 64 + cc]));
    if (bvec) v += bvec[n0 + cc];
    out[(size_t)j * ostride + n0 + cc] = v;
  }
  __syncthreads();
}

DI void transpose_strip(const float* W, int ldn, int k0, int n0, bf16_t* WT, char* lds, bool f16) {
  const int tid = get_tid();
  float* tl = (float*)lds;
  const int nn = tid & 63, kb = tid >> 6;
  float r[4][8];
#pragma unroll
  for (int t4 = 0; t4 < 4; ++t4)
#pragma unroll
    for (int i = 0; i < 8; ++i) r[t4][i] = W[(size_t)(k0 + kb + 8 * i) * ldn + n0 + t4 * 64 + nn];
#pragma unroll
  for (int t4 = 0; t4 < 4; ++t4)
#pragma unroll
    for (int i = 0; i < 8; ++i) tl[t4 * 4160 + (kb + 8 * i) * 65 + nn] = r[t4][i];
  __syncthreads();
  const int n2 = tid >> 3, ch = tid & 7;
#pragma unroll
  for (int t4 = 0; t4 < 4; ++t4) {
    u32x4 o;
#pragma unroll
    for (int j = 0; j < 4; ++j)
    {
      const float a_ = tl[t4 * 4160 + (ch * 8 + 2 * j) * 65 + n2], b_ = tl[t4 * 4160 + (ch * 8 + 2 * j + 1) * 65 + n2];
      o[j] = f16 ? pkh2(a_, b_) : pk2(a_, b_);
    }
    *(u32x4*)(WT + (size_t)(n0 + t4 * 64 + n2) * DM + k0 + ch * 8) = o;
  }
  __syncthreads();
}

DI void phase0(const Params& p, char* lds) {
  constexpr int N_MOD = NL * 48, N_TR = NL * 240, N_PW = 16;
  const int total = N_MOD + N_TR + N_PW + 1;
  for (int it = get_bid(); it < total; it += gridDim.x) {
    if (it < N_MOD) {
      const int l = it / 48, nc = it % 48;
      gemv17(p.c, DM, p.c_ctx, true, p.w_mod + (size_t)l * DM * 3072, 3072, nc * 64, p.b_mod + l * 3072,
             p.mod + (size_t)l * 17 * 3072, 3072, lds);
    } else if (it < N_MOD + N_TR) {
      const int q = it - N_MOD;
      const int l = q / 240, t = q % 240;
      if (t < 176) {
        const int kt = t / 11, ns = t % 11;
        transpose_strip(p.w_in + (size_t)l * DM * INW, INW, kt * 64, ns * 256, p.WinT + (size_t)l * INW * DM, lds, true);
      } else {
        const int t2 = t - 176;
        const int kt = t2 / 4, ns = t2 % 4;
        transpose_strip(p.w_out + (size_t)l * DM * DM, DM, kt * 64, ns * 256, p.WoutT + (size_t)l * DM * DM, lds, false);
      }
    } else if (it < N_MOD + N_TR + N_PW) {
      const int q = it - N_MOD - N_TR;
      const float* src = p.pool_w + (size_t)q * 4096;
      bf16_t* dst = p.pwT + (size_t)q * 4096;
      for (int e = get_tid(); e < 4096; e += NTHREADS) {
        const int o = e >> 6, i = e & 63;
        dst[e] = (bf16_t)(pk2(src[i * 64 + o], 0.f) & 0xffffu);
      }
    } else {
      for (int e = get_tid(); e < 64 * 16; e += NTHREADS) {
        const int pos = e >> 4, j = e & 15;
        const float inv = powf(10000.0f, -(float)j / 16.0f);
        const float ang = (float)pos * inv;
        p.rope[e * 2] = cosf(ang);
        p.rope[e * 2 + 1] = sinf(ang);
      }
    }
  }
}

DI void phase0b(const Params& p, char* lds) {
  constexpr int N_B = NL * 44;
  const int total = N_B + NTOK / 64;
  const int tid = get_tid(), lane = tid & 63, w = tid >> 6;
  for (int it = get_bid(); it < total; it += gridDim.x) {
    if (it < N_B) {
      const int l = it / 44, nc = it % 44;
      gemv17(p.mod + (size_t)l * 17 * 3072, 3072, p.mod + (size_t)(l * 17 + 16) * 3072, false,
             p.w_in + (size_t)l * DM * INW, INW, nc * 64, nullptr, p.bias + (size_t)l * 17 * INW, INW, lds);
    } else {
      const int rb = (it - N_B) * 64;
      const int modrow = rb < NLAT ? rb / SEQ : 16;
      const float* scp = p.mod + (size_t)modrow * 3072 + 1024;
      f32x4 gsv[4];
#pragma unroll
      for (int pp = 0; pp < 4; ++pp) {
        const int k = pp * 256 + lane * 4;
        const f32x4 g = *(const f32x4*)(p.norm_gain + k);
        const f32x4 sc = *(const f32x4*)(scp + k);
#pragma unroll
        for (int j = 0; j < 4; ++j) gsv[pp][j] = g[j] * (1.f + sc[j]);
      }
#pragma unroll
      for (int qb = 0; qb < 2; ++qb) {
        f32x4 xv[4][4];
#pragma unroll
        for (int q = 0; q < 4; ++q) {
          const int row = rb + w * 8 + qb * 4 + q;
          const float* src = row < NLAT ? p.x + (size_t)row * DM : p.ctx + (size_t)(row - NLAT) * DM;
#pragma unroll
          for (int pp = 0; pp < 4; ++pp) xv[q][pp] = *(const f32x4*)(src + pp * 256 + lane * 4);
        }
#pragma unroll
        for (int q = 0; q < 4; ++q) {
          const int row = rb + w * 8 + qb * 4 + q;
          float ss = 0.f;
#pragma unroll
          for (int pp = 0; pp < 4; ++pp) {
            const f32x4 v = xv[q][pp];
            ss += (v[0] * v[0] + v[1] * v[1]) + (v[2] * v[2] + v[3] * v[3]);
            u32x2 o;
            o[0] = pkh2(v[0] * gsv[pp][0], v[1] * gsv[pp][1]);
            o[1] = pkh2(v[2] * gsv[pp][2], v[3] * gsv[pp][3]);
            *(u32x2*)(p.xg + (size_t)row * DM + pp * 256 + lane * 4) = o;
          }
#pragma unroll
          for (int m = 1; m < 64; m <<= 1) ss += __shfl_xor(ss, m);
          if (lane < 16) p.ssq[(size_t)row * 16 + lane] = (lane == 0) ? ss : 0.f;
        }
      }
    }
  }
}

DI void tile_map(int it, int nF, int nT, int& pf, int& pt) {
  const int nwg = nF * nT;
  const int q = nwg / 8, r = nwg % 8, xcd = it % 8, off = it / 8;
  const int wgid = (xcd < r ? xcd * (q + 1) : r * (q + 1) + (xcd - r) * q) + off;
  constexpr int WGM = 8;
  const int nig = WGM * nT, gid = wgid / nig, fm = gid * WGM, gsz = (nF - fm) < WGM ? (nF - fm) : WGM;
  pf = fm + ((wgid % nig) % gsz);
  pt = (wgid % nig) / gsz;
}

DI void publish_count(unsigned* cnt) {
  asm volatile("s_waitcnt vmcnt(0)" ::: "memory");
  __syncthreads();
  if (get_tid() == 0) {
    __builtin_amdgcn_fence(__ATOMIC_RELEASE, "agent");
    asm volatile("s_waitcnt vmcnt(0)" ::: "memory");
    (void)__hip_atomic_fetch_add(cnt, 1u, __ATOMIC_RELAXED, __HIP_MEMORY_SCOPE_AGENT);
  }
}
DI void wait_count(unsigned* cnt, unsigned target) {
  if (get_tid() == 0) {
    while (__hip_atomic_load(cnt, __ATOMIC_RELAXED, __HIP_MEMORY_SCOPE_AGENT) < target) __builtin_amdgcn_s_sleep(1);
    __builtin_amdgcn_fence(__ATOMIC_ACQUIRE, "agent");
    asm volatile("s_waitcnt vmcnt(0)" ::: "memory");
  }
  __syncthreads();
}

DI void phaseA(const Params& p, int l, char* lds) {
  const bool last = (l == NL - 1);
  constexpr int NF = INW / 256;
  constexpr int NLT = NLAT / 256, NCT = NCTX / 256;
  const int nPre = (l > 0) ? NCT * 4 : 0;
  const int nLat = NF * NLT;
  const int nCtx = last ? NCT * 3 : NCT * NF;
  const int total = nPre + nLat + nCtx;
  unsigned* cnt = p.bar + 3584 + 64 * l;
  constexpr int PRE0 = 192;
  for (int it = get_bid(); it < total; it += gridDim.x) {
    if (nPre && it >= PRE0 && it < PRE0 + nPre) {
      const int e = it - PRE0;
      phaseC_tile(p, l - 1, e & 3, NLT + (e >> 2), lds);
      publish_count(cnt);
      continue;
    }
    int pf, pt;
    if (it < nPre + nLat) tile_map((nPre && it >= PRE0) ? it - nPre : it, NF, NLT, pf, pt);
    else {
      const int e = it - nPre - nLat;
      if (last) { pt = NLT + e / 3; const int k = e % 3; pf = (k == 0) ? 2 : (7 + k); }
      else { pt = NLT + e / NF; pf = e % NF; }
      if (nPre) wait_count(cnt, (unsigned)nPre);
    }
    phaseA_tile(p, l, pf, pt, lds);
  }
}

DI void phaseB(const Params& p, int l, char* lds) {
  const bool last = (l == NL - 1);
  const int nG = 1024, nN = 512, nCA = last ? 0 : 128, nCN = last ? 0 : 64, nP = last ? 512 : 576;
  const int nAttn = nG + nN + nCA + nCN;
  const int total = nAttn + nP;
  bool track;
  {
    const int ln = get_tid() & 63;
    float a = fabsf(p.att_q_gain[l * 64 + ln]), bq = fabsf(p.att_k_gain[l * 64 + ln]);
    float c = fabsf(p.na_q_gain[l * 64 + ln]), dk = fabsf(p.na_k_gain[l * 64 + ln]);
#pragma unroll
    for (int m = 1; m < 64; m <<= 1) {
      a = fmaxf(a, __shfl_xor(a, m)); bq = fmaxf(bq, __shfl_xor(bq, m));
      c = fmaxf(c, __shfl_xor(c, m)); dk = fmaxf(dk, __shfl_xor(dk, m));
    }
    const float bound = 64.f * 0.125f * LOG2E * 1.02f * fmaxf(a * bq, c * dk);
    track = !(__builtin_amdgcn_readfirstlane(__float_as_int(bound)) <= __float_as_int(40.f));
  }
  for (int it = get_bid(); it < total; it += gridDim.x) {
    if (it >= nAttn) { pool_item(p, l, (it - nAttn) * 64, lds); continue; }
    int idx = it;
    bool na = false, isN;
    int rq = 0, b, head, kvh, qrow, k1row = 0, nt1 = 0, vk1 = 0, rlo = 0;
    if (idx < nG) {
      const int rd = idx >> 8, j = idx & 255, xx = j & 7, y = j >> 3;
      const int grp = rd * 8 + xx;
      b = grp >> 1; kvh = grp & 1; head = kvh * 4 + (y >> 3);
      qrow = b * SEQ + (y & 7) * 256; k1row = b * SEQ; nt1 = 32; vk1 = 0; isN = false;
    } else if (idx < nG + nN) {
      idx -= nG;
      b = idx >> 5; const int rem = idx & 31; head = rem >> 3; kvh = head; rq = rem & 7;
      rlo = clampi(4 * rq - 4, 0, 24);
      const int rhi = clampi(4 * rq + 3 - 4, 0, 24);
      nt1 = rhi + 8 - rlo; qrow = b * SEQ + rq * 256; k1row = b * SEQ + rlo * 64; vk1 = rlo * 64; isN = true; na = true;
    } else if (idx < nG + nN + nCA) {
      idx -= nG + nN;
      b = idx >> 3; head = idx & 7; kvh = head >> 2; qrow = NLAT + b * CTX; isN = false;
    } else {
      idx -= nG + nN + nCA;
      b = idx >> 2; head = idx & 3; kvh = head; qrow = NLAT + b * CTX; isN = true;
    }
    const int qcol = isN ? 1792 + head * 64 : head * 64;
    const int kcol = isN ? 2048 + kvh * 64 : 512 + kvh * 64;
    const int gcol = isN ? 2560 + head * 64 : 768 + head * 64;
    const int ycol = isN ? 768 + head * 64 : head * 64;
    const bf16_t* vt = isN ? p.VtN + (size_t)((b * 4 + kvh) * 64) * KEYS : p.VtA + (size_t)((b * 2 + kvh) * 64) * KEYS;
    if (na)
      attn_item<true, true>(lds, p.P, p.Y, vt, rq, qrow * INW + qcol, k1row * INW + kcol, nt1, vk1,
                            (NLAT + b * CTX) * INW + kcol, 4, SEQ, qrow * INW + gcol, qrow * DM + ycol, rlo,
                            p.na_rpb + (size_t)(l * 4 + head) * 465);
    else if (track)
      attn_item<false, true>(lds, p.P, p.Y, vt, rq, qrow * INW + qcol, k1row * INW + kcol, nt1, vk1,
                             (NLAT + b * CTX) * INW + kcol, 4, SEQ, qrow * INW + gcol, qrow * DM + ycol, rlo, nullptr);
    else
      attn_item<false, false>(lds, p.P, p.Y, vt, rq, qrow * INW + qcol, k1row * INW + kcol, nt1, vk1,
                              (NLAT + b * CTX) * INW + kcol, 4, SEQ, qrow * INW + gcol, qrow * DM + ycol, rlo, nullptr);
  }
}

DI void phaseC(const Params& p, int l, char* lds) {
  constexpr int nT = NLAT / 256;
  const int total = 4 * nT;
  for (int it = get_bid(); it < total; it += gridDim.x) {
    int pf, pt;
    tile_map(it, 4, nT, pf, pt);
    phaseC_tile(p, l, pf, pt, lds);
  }
}

DI void grid_bar(unsigned* bar, unsigned target) {
  asm volatile("s_waitcnt vmcnt(0)" ::: "memory");
  __syncthreads();
  if (get_tid() == 0) {
    __builtin_amdgcn_fence(__ATOMIC_RELEASE, "agent");
    asm volatile("s_waitcnt vmcnt(0)" ::: "memory");
    (void)__hip_atomic_fetch_add(bar, 1u, __ATOMIC_RELAXED, __HIP_MEMORY_SCOPE_AGENT);
    while (__hip_atomic_load(bar, __ATOMIC_RELAXED, __HIP_MEMORY_SCOPE_AGENT) < target) __builtin_amdgcn_s_sleep(1);
    __builtin_amdgcn_fence(__ATOMIC_ACQUIRE, "agent");
    asm volatile("s_waitcnt vmcnt(0)" ::: "memory");
  }
  __syncthreads();
}


#define XB_TMO      128
#define XB_XCNT(j)  (256  + 64 * (j))
#define XB_XSUB(j)  (1280 + 64 * (j))
#define XB_XGEN(j)  (2304 + 64 * (j))
#define XB_TOP      3328
#define XB_TOPGEN   3392
#define XB_SPIN_CAP (1u << 22)
typedef volatile __attribute__((address_space(3))) unsigned* xb_lds_p;
DI unsigned xb_ld(unsigned* p) { return __hip_atomic_load(p, __ATOMIC_RELAXED, __HIP_MEMORY_SCOPE_AGENT); }
DI unsigned xb_add(unsigned* p, unsigned v) { return __hip_atomic_fetch_add(p, v, __ATOMIC_RELAXED, __HIP_MEMORY_SCOPE_AGENT); }
DI unsigned xb_xcc_id() { return (unsigned)__builtin_amdgcn_s_getreg((3 << 11) | 20) & 0xFu; }
#define XB_SPIN(cond, bar) do { unsigned _sp = 0; while (cond) { __builtin_amdgcn_s_sleep(1); \
    if ((++_sp & 255u) == 0u) { if (xb_ld(&(bar)[XB_TMO])) break; if (_sp > XB_SPIN_CAP) { atomicAdd(&(bar)[XB_TMO], 1u); break; } } } } while (0)

DI void xcd_barrier_post(unsigned* bar) {
  if (get_tid() == 0) (void)xb_add(&bar[XB_XCNT(xb_xcc_id())], 1u);
}
DI void xcd_barrier_complete(unsigned* bar, unsigned x, unsigned& nloc, unsigned& nx) {
  const unsigned G = gridDim.x * gridDim.y * gridDim.z;
  unsigned sum, cnt, mine, sp = 0u;
  for (;;) {
    sum = 0u; cnt = 0u; mine = 0u;
#pragma unroll
    for (unsigned j = 0; j < 16; ++j) { const unsigned c = xb_ld(&bar[XB_XCNT(j)]); sum += c; cnt += (c > 0u) ? 1u : 0u; mine = (j == x) ? c : mine; }
    if (sum == G) break;
    __builtin_amdgcn_s_sleep(1);
    if ((++sp & 255u) == 0u) { if (xb_ld(&bar[XB_TMO])) break; if (sp > XB_SPIN_CAP) { atomicAdd(&bar[XB_TMO], 1u); break; } }
  }
  nloc = mine > 0u ? mine : 1u; nx = cnt > 0u ? cnt : 1u;
}
DI void xcd_barrier(unsigned* bar, xb_lds_p st) {
  asm volatile("s_waitcnt vmcnt(0)" ::: "memory");
  __syncthreads();
  if (get_tid() == 0) {
    const unsigned x = xb_xcc_id();
    __builtin_amdgcn_s_waitcnt(0);
    unsigned nloc = st[0], nx = st[1];
    if (nloc == 0u) { xcd_barrier_complete(bar, x, nloc, nx); st[0] = nloc; st[1] = nx; }
    const unsigned old = xb_add(&bar[XB_XSUB(x)], 1u);
    const unsigned gen = old / nloc;
    if (old + 1u == (gen + 1u) * nloc) {
      __builtin_amdgcn_fence(__ATOMIC_RELEASE, "agent");
      asm volatile("s_waitcnt vmcnt(0)" ::: "memory");
      const unsigned og = xb_add(&bar[XB_TOP], 1u);
      const unsigned tg = og / nx;
      if (og + 1u == (tg + 1u) * nx) xb_add(&bar[XB_TOPGEN], 1u);
      else XB_SPIN(xb_ld(&bar[XB_TOPGEN]) == tg, bar);
      __builtin_amdgcn_fence(__ATOMIC_ACQUIRE, "agent");
      xb_add(&bar[XB_XGEN(x)], 1u);
      asm volatile("s_waitcnt vmcnt(0)" ::: "memory");
    } else {
      XB_SPIN(xb_ld(&bar[XB_XGEN(x)]) == gen, bar);
      __builtin_amdgcn_fence(__ATOMIC_ACQUIRE, "agent");
      asm volatile("s_waitcnt vmcnt(0)" ::: "memory");
    }
  }
  __syncthreads();
}

constexpr int NPHASE = 2 + 3 * NL;
__global__ void __launch_bounds__(NTHREADS, 2) fwd_kernel(Params p_arg, int ph_begin, int ph_end) {
  __shared__ __attribute__((aligned(16))) char lds[LDS_BYTES];
  (void)p_arg;
#if defined(__HIP_DEVICE_COMPILE__)
  xb_lds_p xst = (xb_lds_p)(lds + 131072 + 7680);
  {
    Params p0_;
    reload_params(p0_);
    if (get_tid() == 0) { xst[0] = 0u; xst[1] = 0u; }
    __syncthreads();
    xcd_barrier_post(p0_.bar);
  }
  for (int ph = ph_begin; ph < ph_end; ++ph) {
    Params p;
    reload_params(p);
    if (ph == 0) phase0(p, lds);
    else if (ph == 1) phase0b(p, lds);
    else {
      const int l = (ph - 2) / 3, k = (ph - 2) % 3;
      if (k == 0) phaseA(p, l, lds);
      else if (k == 1) phaseB(p, l, lds);
      else phaseC(p, l, lds);
    }
    if (ph + 1 < ph_end) {
      if (ph_end > 1000) cg::this_grid().sync();
      xcd_barrier(p.bar, xst);
    }
  }
#endif
}

static inline size_t align_up(size_t v, size_t a) { return (v + a - 1) / a * a; }

extern "C" void kernel_launch(void* const* d_in, const int* in_sizes, int n_in, void* d_out, int out_size, void* d_ws,
                              size_t ws_size, hipStream_t stream) {
  (void)in_sizes; (void)n_in; (void)out_size; (void)ws_size;
  Params p{};
  p.x = (const float*)d_in[0]; p.c = (const float*)d_in[1]; p.ctx = (const float*)d_in[2]; p.c_ctx = (const float*)d_in[3];
  p.norm_gain = (const float*)d_in[4]; p.w_mod = (const float*)d_in[5]; p.b_mod = (const float*)d_in[6];
  p.w_in = (const float*)d_in[7]; p.att_q_gain = (const float*)d_in[8]; p.att_k_gain = (const float*)d_in[9];
  p.pool_w = (const float*)d_in[10]; p.pool_scale = (const float*)d_in[11]; p.na_q_gain = (const float*)d_in[12];
  p.na_k_gain = (const float*)d_in[13]; p.na_rpb = (const float*)d_in[14]; p.w_out = (const float*)d_in[15];
  p.out = (float*)d_out;
  char* ws = (char*)d_ws;
  size_t off = 0;
  auto take = [&](size_t bytes) { char* q = ws + off; off = align_up(off + bytes, 256); return q; };
  p.bar = (unsigned*)take(16384);
  p.WinT = (bf16_t*)take((size_t)NL * INW * DM * 2);
  p.WoutT = (bf16_t*)take((size_t)NL * DM * DM * 2);
  p.pwT = (bf16_t*)take((size_t)NL * 4 * 64 * 64 * 2);
  p.xg = (bf16_t*)take((size_t)NTOK * DM * 2);
  p.P = (bf16_t*)take((size_t)NTOK * INW * 2);
  p.VtA = (bf16_t*)take((size_t)NB * 2 * 64 * KEYS * 2);
  p.VtN = (bf16_t*)take((size_t)NB * 4 * 64 * KEYS * 2);
  p.Y = (bf16_t*)take((size_t)NTOK * DM * 2);
  p.mod = (float*)take((size_t)NL * 17 * 3072 * 4);
  p.bias = (float*)take((size_t)NL * 17 * INW * 4);
  p.rope = (float*)take((size_t)64 * 16 * 2 * 4);
  p.Cbuf = (float*)take((size_t)NCTX * DM * 4);
  p.ssq = (float*)take((size_t)NTOK * 16 * 4);

  static int grid_blocks = 0;
  if (!grid_blocks) {
    int dev = 0, cus = 0, per_cu = 0;
    hipGetDevice(&dev);
    hipDeviceGetAttribute(&cus, hipDeviceAttributeMultiprocessorCount, dev);
    hipOccupancyMaxActiveBlocksPerMultiprocessor(&per_cu, fwd_kernel, NTHREADS, 0);
    if (per_cu > 1) per_cu = 1;
    if (per_cu < 1) per_cu = 1;
    grid_blocks = cus * per_cu;
  }
  hipMemsetAsync(p.bar, 0, 16384, stream);
#ifdef MULTI_LAUNCH
  for (int ph = 0; ph < NPHASE; ++ph) {
    hipLaunchKernelGGL(fwd_kernel, dim3(grid_blocks), dim3(NTHREADS), 0, stream, p, ph, ph + 1);
  }
#else
  int pb = 0, pe = NPHASE;
  void* args[] = {&p, &pb, &pe};
  hipError_t e = hipLaunchCooperativeKernel((void*)fwd_kernel, dim3(grid_blocks), dim3(NTHREADS), args, 0, stream);
  if (e != hipSuccess) fprintf(stderr, "cooperative launch failed: %s (grid %d)\n", hipGetErrorString(e), grid_blocks);
#endif
}
```

```cpp
#include <hip/hip_runtime.h>
#include <hip/hip_cooperative_groups.h>
#include <cstdio>
#include <cstdint>
namespace cg = cooperative_groups;

#define DI __device__ __forceinline__
typedef unsigned short bf16_t;
typedef short bf16x8 __attribute__((ext_vector_type(8)));
typedef float f32x16 __attribute__((ext_vector_type(16)));
typedef float f32x4 __attribute__((ext_vector_type(4)));
typedef float f32x2 __attribute__((ext_vector_type(2)));
typedef unsigned u32x4 __attribute__((ext_vector_type(4)));
typedef unsigned u32x2 __attribute__((ext_vector_type(2)));
typedef __bf16 bf2_t __attribute__((ext_vector_type(2)));

constexpr int DM = 1024, NB = 16, SEQ = 2048, NL = 4, CTX = 256, INW = 2816;
constexpr int NLAT = NB * SEQ, NCTX = NB * CTX, NTOK = NLAT + NCTX;
constexpr int KEYS = SEQ + CTX;
constexpr float LOG2E = 1.4426950408889634f;
constexpr float EPS = 1e-6f;
constexpr int LDS_BYTES = 131072 + 7680 + 16;
#ifndef NTHREADS
#define NTHREADS 512
#endif

struct Params {
  const float *x, *c, *ctx, *c_ctx, *norm_gain, *w_mod, *b_mod, *w_in, *att_q_gain, *att_k_gain, *pool_w, *pool_scale,
      *na_q_gain, *na_k_gain, *na_rpb, *w_out;
  float* out;
  bf16_t *WinT, *WoutT, *pwT, *xg, *P, *VtA, *VtN, *Y;
  float *mod, *bias, *rope, *Cbuf, *ssq;
  unsigned* bar;
};

DI int get_tid() { int t = threadIdx.x; asm volatile("" : "+v"(t)); return t; }
DI int get_bid() { int t = blockIdx.x; asm volatile("" : "+s"(t)); return t; }
DI void launder_s(int& v) { asm volatile("" : "+s"(v)); }
DI unsigned pk2(float a, float b) {
  bf2_t v = __builtin_convertvector((f32x2){a, b}, bf2_t);
  return __builtin_bit_cast(unsigned, v);
}
typedef _Float16 h2_t __attribute__((ext_vector_type(2)));
typedef _Float16 f16x8 __attribute__((ext_vector_type(8)));
DI unsigned pkh2(float a, float b) {
  h2_t v = __builtin_convertvector((f32x2){a, b}, h2_t);
  return __builtin_bit_cast(unsigned, v);
}
DI float hlo(unsigned u) { const h2_t v = __builtin_bit_cast(h2_t, u); return (float)v[0]; }
DI float hhi(unsigned u) { const h2_t v = __builtin_bit_cast(h2_t, u); return (float)v[1]; }
DI float bflo(unsigned u) { return __uint_as_float(u << 16); }
DI float bfhi(unsigned u) { return __uint_as_float(u & 0xffff0000u); }
DI f32x16 mfma32(bf16x8 a, bf16x8 b, f32x16 c) { return __builtin_amdgcn_mfma_f32_32x32x16_bf16(a, b, c, 0, 0, 0); }
DI float fast_exp2(float x) { return __builtin_amdgcn_exp2f(x); }
DI float silu_f(float v) { return v * __builtin_amdgcn_rcpf(1.f + __expf(-v)); }
DI int clampi(int v, int lo, int hi) { return v < lo ? lo : (v > hi ? hi : v); }
DI f32x16 zero16() {
  f32x16 z;
#pragma unroll
  for (int i = 0; i < 16; ++i) z[i] = 0.f;
  return z;
}

constexpr int G_BK = 64, G_HALF = 128, G_HT = G_HALF * G_BK;
DI int lds_byte(int r, int c) {
  const int st = (r >> 4) * 2 + (c >> 5), rr = r & 15, cc = c & 31, ob = rr * 64 + cc * 2;
  return st * 1024 + (ob ^ (((ob >> 9) & 1) << 5));
}
DI void stage_rc(int b, int& R, int& C) {
  const int st = b / 1024, sb = b % 1024, swz = sb ^ (((sb >> 9) & 1) << 5);
  R = (st >> 1) * 16 + swz / 64; C = (st & 1) * 32 + (swz % 64) / 2;
}
typedef __attribute__((address_space(3))) unsigned* lds_u32p;
typedef const __attribute__((address_space(1))) unsigned* glb_u32p;

template <bool F16>
DI void gemm256(const bf16_t* __restrict__ A, const bf16_t* __restrict__ Bt, int brow, int bcol, char* ldsc,
                f32x4 (&acc)[2][2][4][2]) {
  bf16_t* shm = (bf16_t*)ldsc;
  const int tid = get_tid();
  constexpr int K = DM;
#define SA(b, h) (shm + ((b) * 2 + (h)) * G_HT)
#define SB(b, h) (shm + (4 + (b) * 2 + (h)) * G_HT)
#define STAGE(P, BASE, br, kt) do { const char* _sb = (const char*)((BASE) + (long)(br) * K + (long)(kt) * G_BK); \
    _Pragma("unroll") for (int _i = 0; _i < 2; ++_i) { \
      __builtin_amdgcn_global_load_lds((glb_u32p)(_sb + (size_t)voff[_i]), \
        (lds_u32p)((char*)(P) + tid * 16 + _i * 8192), 16, 0, 0); } } while (0)
#define LDA(dst, b, h) _Pragma("unroll") for (int m = 0; m < 4; ++m) _Pragma("unroll") for (int k = 0; k < 2; ++k) \
    dst[m][k] = *reinterpret_cast<const bf16x8*>((char*)SA(b, h) + lds_byte(wr * 64 + m * 16 + fr, k * 32 + fq * 8))
#define LDB(dst, b, h) _Pragma("unroll") for (int n = 0; n < 2; ++n) _Pragma("unroll") for (int k = 0; k < 2; ++k) \
    dst[n][k] = *reinterpret_cast<const bf16x8*>((char*)SB(b, h) + lds_byte(wc * 32 + n * 16 + fr, k * 32 + fq * 8))
#define MMA(ai, bj, At, Bt_) do { __builtin_amdgcn_s_setprio(1); \
    _Pragma("unroll") for (int m = 0; m < 4; ++m) _Pragma("unroll") for (int n = 0; n < 2; ++n) _Pragma("unroll") for (int k = 0; k < 2; ++k) \
      acc[ai][bj][m][n] = F16 ? __builtin_amdgcn_mfma_f32_16x16x32_f16(__builtin_bit_cast(f16x8, At[m][k]), __builtin_bit_cast(f16x8, Bt_[n][k]), acc[ai][bj][m][n], 0, 0, 0) \
                              : __builtin_amdgcn_mfma_f32_16x16x32_bf16(At[m][k], Bt_[n][k], acc[ai][bj][m][n], 0, 0, 0); \
    __builtin_amdgcn_s_setprio(0); } while (0)
#define WAIT_V(n) asm volatile("s_waitcnt vmcnt(" #n ")" ::: "memory")
#define WAIT_L(n) asm volatile("s_waitcnt lgkmcnt(" #n ")" ::: "memory")
#define BAR __builtin_amdgcn_s_barrier()
#define SCHED __builtin_amdgcn_sched_barrier(0)
  const int wid = tid >> 6, lane = tid & 63, wr = wid >> 2, wc = wid & 3, fr = lane & 15, fq = lane >> 4;
  bf16x8 At[4][2], B0[2][2], B1[2][2];
  constexpr int nt = K / G_BK;
  unsigned voff[2];
#pragma unroll
  for (int i = 0; i < 2; ++i) { int r_, c_; stage_rc(tid * 16 + i * 8192, r_, c_); voff[i] = (unsigned)((r_ * K + c_) * 2); }
  STAGE(SB(0, 0), Bt, bcol, 0); STAGE(SB(0, 1), Bt, bcol + G_HALF, 0); STAGE(SA(0, 0), A, brow, 0); STAGE(SA(0, 1), A, brow + G_HALF, 0);
  if (wr == 1) BAR;
  WAIT_V(2); BAR;
  STAGE(SB(1, 0), Bt, bcol, 1); STAGE(SA(1, 0), A, brow, 1); STAGE(SB(1, 1), Bt, bcol + G_HALF, 1);
  WAIT_V(6); BAR;
  for (int t = 0; t < nt; t += 2) {
    const bool last = (t == nt - 2);
    const int k2 = last ? 0 : t + 2, k3 = last ? 1 : t + 3;
    LDB(B0, 0, 0); LDB(B1, 0, 1); SCHED; LDA(At, 0, 0); STAGE(SA(1, 1), A, brow + G_HALF, t + 1);
    WAIT_V(8); WAIT_L(0); BAR; MMA(0, 0, At, B0); MMA(0, 1, At, B1); BAR; SCHED;
    LDA(At, 0, 1); STAGE(SB(0, 0), Bt, bcol, k2); STAGE(SB(0, 1), Bt, bcol + G_HALF, k2); STAGE(SA(0, 0), A, brow, k2);
    WAIT_V(8); WAIT_L(0); BAR; MMA(1, 0, At, B0); MMA(1, 1, At, B1); BAR; SCHED;
    LDB(B0, 1, 0); LDB(B1, 1, 1); SCHED; LDA(At, 1, 0); STAGE(SA(0, 1), A, brow + G_HALF, k2);
    WAIT_V(8); WAIT_L(0); BAR; MMA(0, 0, At, B0); MMA(0, 1, At, B1); BAR; SCHED;
    LDA(At, 1, 1); STAGE(SB(1, 0), Bt, bcol, k3); STAGE(SB(1, 1), Bt, bcol + G_HALF, k3); STAGE(SA(1, 0), A, brow, k3);
    WAIT_V(8); WAIT_L(0); BAR; MMA(1, 0, At, B0); MMA(1, 1, At, B1); BAR; SCHED;
  }
  WAIT_V(0);
  if (wr == 0) BAR;
  BAR;
#undef SA
#undef SB
#undef STAGE
#undef LDA
#undef LDB
#undef MMA
}

typedef const __attribute__((address_space(4))) char* KCharPtr;
DI void reload_params(Params& p) {
#if defined(__HIP_DEVICE_COMPILE__)
  KCharPtr base = (KCharPtr)__builtin_amdgcn_kernarg_segment_ptr();
  asm volatile("" : "+s"(base));
  const __attribute__((address_space(4))) uint64_t* q = (const __attribute__((address_space(4))) uint64_t*)base;
  p.x = (const float*)(__attribute__((address_space(1))) const float*)q[0];
  p.c = (const float*)(__attribute__((address_space(1))) const float*)q[1];
  p.ctx = (const float*)(__attribute__((address_space(1))) const float*)q[2];
  p.c_ctx = (const float*)(__attribute__((address_space(1))) const float*)q[3];
  p.norm_gain = (const float*)(__attribute__((address_space(1))) const float*)q[4];
  p.w_mod = (const float*)(__attribute__((address_space(1))) const float*)q[5];
  p.b_mod = (const float*)(__attribute__((address_space(1))) const float*)q[6];
  p.w_in = (const float*)(__attribute__((address_space(1))) const float*)q[7];
  p.att_q_gain = (const float*)(__attribute__((address_space(1))) const float*)q[8];
  p.att_k_gain = (const float*)(__attribute__((address_space(1))) const float*)q[9];
  p.pool_w = (const float*)(__attribute__((address_space(1))) const float*)q[10];
  p.pool_scale = (const float*)(__attribute__((address_space(1))) const float*)q[11];
  p.na_q_gain = (const float*)(__attribute__((address_space(1))) const float*)q[12];
  p.na_k_gain = (const float*)(__attribute__((address_space(1))) const float*)q[13];
  p.na_rpb = (const float*)(__attribute__((address_space(1))) const float*)q[14];
  p.w_out = (const float*)(__attribute__((address_space(1))) const float*)q[15];
  p.out = (float*)(__attribute__((address_space(1))) float*)q[16];
  p.WinT = (bf16_t*)(__attribute__((address_space(1))) bf16_t*)q[17];
  p.WoutT = (bf16_t*)(__attribute__((address_space(1))) bf16_t*)q[18];
  p.pwT = (bf16_t*)(__attribute__((address_space(1))) bf16_t*)q[19];
  p.xg = (bf16_t*)(__attribute__((address_space(1))) bf16_t*)q[20];
  p.P = (bf16_t*)(__attribute__((address_space(1))) bf16_t*)q[21];
  p.VtA = (bf16_t*)(__attribute__((address_space(1))) bf16_t*)q[22];
  p.VtN = (bf16_t*)(__attribute__((address_space(1))) bf16_t*)q[23];
  p.Y = (bf16_t*)(__attribute__((address_space(1))) bf16_t*)q[24];
  p.mod = (float*)(__attribute__((address_space(1))) float*)q[25];
  p.bias = (float*)(__attribute__((address_space(1))) float*)q[26];
  p.rope = (float*)(__attribute__((address_space(1))) float*)q[27];
  p.Cbuf = (float*)(__attribute__((address_space(1))) float*)q[28];
  p.ssq = (float*)(__attribute__((address_space(1))) float*)q[29];
  p.bar = (unsigned*)(__attribute__((address_space(1))) unsigned*)q[30];
#else
  (void)p;
#endif
}

DI void zero_acc(f32x4 (&acc)[2][2][4][2]) {
#pragma unroll
  for (int a = 0; a < 2; ++a)
#pragma unroll
    for (int b = 0; b < 2; ++b)
#pragma unroll
      for (int m = 0; m < 4; ++m)
#pragma unroll
        for (int n = 0; n < 2; ++n) acc[a][b][m][n] = (f32x4){0.f, 0.f, 0.f, 0.f};
}

DI void phaseA_tile(const Params& p0, int l, int ft, int mt, char* lds) {
  f32x4 acc[2][2][4][2];
  zero_acc(acc);
  gemm256<true>(p0.WinT + (size_t)l * INW * DM, p0.xg, ft * 256, mt * 256, lds, acc);
  launder_s(l); launder_s(ft); launder_s(mt);
  Params p; reload_params(p);
  const int n0 = ft * 256, m0 = mt * 256;
  const int tid = get_tid(), lane = tid & 63, wid = tid >> 6, wr = wid >> 2, wc = wid & 3, fr = lane & 15, fq = lane >> 4;

  const bool is_ctx = m0 >= NLAT;
  int b, s_base, modrow;
  if (!is_ctx) { b = m0 / SEQ; s_base = m0 % SEQ; modrow = b; }
  else { const int c = m0 - NLAT; b = c / CTX; s_base = c % CTX; modrow = 16; }
  int tl[4];
#pragma unroll
  for (int g = 0; g < 4; ++g) tl[g] = (g >> 1) * 128 + wc * 32 + (g & 1) * 16 + fr;
  f32x4 bvA[2][4];
  {
    const float* bb = p.bias + (size_t)(l * 17 + modrow) * INW + n0 + wr * 64 + fq * 4;
#pragma unroll
    for (int ai = 0; ai < 2; ++ai)
#pragma unroll
      for (int m = 0; m < 4; ++m) bvA[ai][m] = *(const f32x4*)(bb + ai * 128 + m * 16);
  }
  float rstd[4];
#pragma unroll
  for (int gp = 0; gp < 2; ++gp) {
    f32x4 sq[2][4];
#pragma unroll
    for (int n = 0; n < 2; ++n) {
      const f32x4* sp = (const f32x4*)(p.ssq + (size_t)(m0 + tl[gp * 2 + n]) * 16);
#pragma unroll
      for (int q = 0; q < 4; ++q) sq[n][q] = sp[q];
    }
#pragma unroll
    for (int n = 0; n < 2; ++n) {
      float ss = 0.f;
#pragma unroll
      for (int q = 0; q < 4; ++q) ss += (sq[n][q][0] + sq[n][q][1]) + (sq[n][q][2] + sq[n][q][3]);
      rstd[gp * 2 + n] = rsqrtf(ss * (1.f / DM) + EPS);
    }
  }
#pragma unroll
  for (int ai = 0; ai < 2; ++ai) {
    const int f0 = n0 + ai * 128 + wr * 64;
    const int hd = f0 >> 6;
    int kind = 0; const float* gain = p.att_q_gain; bool do_rope = false; bool do_scale = false;
    bf16_t* vtb = nullptr;
    if (hd < 8) { kind = 2; gain = p.att_q_gain + l * 64; do_rope = !is_ctx; do_scale = true; }
    else if (hd < 10) { kind = 2; gain = p.att_k_gain + l * 64; do_rope = !is_ctx; }
    else if (hd < 12) { kind = 3; vtb = p.VtA + (size_t)((b * 2 + (hd - 10)) * 64) * KEYS; }
    else if (hd < 20) { kind = 1; }
    else if (hd < 24) { kind = 0; }
    else if (hd < 28) { kind = 1; }
    else if (hd < 32) { kind = 2; gain = p.na_q_gain + l * 64; do_scale = true; }
    else if (hd < 36) { kind = 2; gain = p.na_k_gain + l * 64; }
    else if (hd < 40) { kind = 3; vtb = p.VtN + (size_t)((b * 4 + (hd - 36)) * 64) * KEYS; }
    else { kind = 1; }
    f32x4 bv[4];
#pragma unroll
    for (int m = 0; m < 4; ++m) bv[m] = bvA[ai][m];
    const float sc = do_scale ? 0.125f * LOG2E : 1.f;
#pragma unroll
    for (int gp = 0; gp < 2; ++gp) {
      float v[2][4][4];
#pragma unroll
      for (int n = 0; n < 2; ++n)
#pragma unroll
        for (int m = 0; m < 4; ++m)
#pragma unroll
          for (int j = 0; j < 4; ++j) v[n][m][j] = acc[ai][gp][m][n][j] * rstd[gp * 2 + n] + bv[m][j];
      if (kind == 1) {
#pragma unroll
        for (int n = 0; n < 2; ++n)
#pragma unroll
          for (int m = 0; m < 4; ++m)
#pragma unroll
            for (int j = 0; j < 4; ++j) v[n][m][j] = silu_f(v[n][m][j]);
      } else if (kind == 2) {
        f32x4 gv[4];
#pragma unroll
        for (int m = 0; m < 4; ++m) gv[m] = *(const f32x4*)(gain + m * 16 + fq * 4);
#pragma unroll
        for (int n = 0; n < 2; ++n) {
          float ss = 0.f;
#pragma unroll
          for (int m = 0; m < 4; ++m)
#pragma unroll
            for (int j = 0; j < 4; ++j) ss += v[n][m][j] * v[n][m][j];
          ss += __shfl_xor(ss, 16);
          ss += __shfl_xor(ss, 32);
          const float rn = rsqrtf(ss * (1.f / 64.f) + EPS) * sc;
#pragma unroll
          for (int m = 0; m < 4; ++m)
#pragma unroll
            for (int j = 0; j < 4; ++j) v[n][m][j] *= rn * gv[m][j];
        }
        if (do_rope) {
#pragma unroll
          for (int n = 0; n < 2; ++n) {
            f32x4 cs4[2][2];
            const int s = s_base + tl[gp * 2 + n];
#pragma unroll
            for (int hf = 0; hf < 2; ++hf) {
              const int pos = hf == 0 ? (s >> 6) : (s & 63);
              const float* tb = p.rope + (size_t)pos * 32 + fq * 8;
              cs4[hf][0] = *(const f32x4*)(tb);
              cs4[hf][1] = *(const f32x4*)(tb + 4);
            }
#pragma unroll
            for (int hf = 0; hf < 2; ++hf)
#pragma unroll
              for (int j = 0; j < 4; ++j) {
                const float c = cs4[hf][j >> 1][(j & 1) * 2], sn = cs4[hf][j >> 1][(j & 1) * 2 + 1];
                const float x1 = v[n][2 * hf][j], x2 = v[n][2 * hf + 1][j];
                v[n][2 * hf][j] = x1 * c - x2 * sn;
                v[n][2 * hf + 1][j] = x2 * c + x1 * sn;
              }
          }
        }
      }
      if (kind == 3) {
#pragma unroll
        for (int n = 0; n < 2; ++n) {
          const int kraw = (is_ctx ? SEQ : 0) + s_base + tl[gp * 2 + n];
          const int k16 = kraw & 15;
          const int kidx = (kraw & ~15) | ((k16 & 3) | ((k16 & 4) << 1) | ((k16 & 8) >> 1));
#pragma unroll
          for (int m = 0; m < 4; ++m)
#pragma unroll
            for (int j = 0; j < 4; ++j) {
              const int d = m * 16 + fq * 4 + j;
              const unsigned u = pk2(v[n][m][j], 0.f);
              vtb[(size_t)d * KEYS + kidx] = (bf16_t)(u & 0xffffu);
            }
        }
      } else {
#pragma unroll
        for (int n = 0; n < 2; ++n) {
          const int tlv = tl[gp * 2 + n];
#pragma unroll
          for (int m = 0; m < 4; ++m) {
            u32x2 o;
            o[0] = pk2(v[n][m][0], v[n][m][1]);
            o[1] = pk2(v[n][m][2], v[n][m][3]);
            const int fl = ai * 128 + wr * 64 + m * 16 + fq * 4;
            *(u32x2*)(lds + tlv * 512 + (((fl >> 3) ^ (tlv & 31)) << 4) + ((fl >> 2) & 1) * 8) = o;
          }
        }
      }
    }
  }
  __syncthreads();
  if (ft != 9) {
    const int nch = (ft == 2) ? 16 : 32;
#pragma unroll 4
    for (int i = 0; i < 16; ++i) {
      const int idx = tid + NTHREADS * i;
      const int row = idx >> 5, c = idx & 31;
      if (c < nch) {
        const u32x4 val = *(const u32x4*)(lds + row * 512 + ((c ^ (row & 31)) << 4));
        *(u32x4*)(p.P + (size_t)(m0 + row) * INW + n0 + c * 8) = val;
      }
    }
  }
  __syncthreads();
}

template <bool HN, bool L0>
DI void phaseC_epi(const Params& p, f32x4 (&acc)[2][2][4][2], int l, int n0, int m0) {
  const int tid = get_tid(), lane = tid & 63, wid = tid >> 6, wr = wid >> 2, wc = wid & 3, fr = lane & 15, fq = lane >> 4;
  const bool is_ctx = m0 >= NLAT;
  const int modrow = is_ctx ? 16 : (m0 / SEQ);
  const float* xin0 = is_ctx ? p.ctx : p.x;
  const int rowoff = is_ctx ? NLAT : 0;
  int tok[4];
#pragma unroll
  for (int g = 0; g < 4; ++g) tok[g] = m0 + (g >> 1) * 128 + wc * 32 + (g & 1) * 16 + fr;
#pragma unroll
  for (int ai = 0; ai < 2; ++ai) {
    const int f0 = n0 + ai * 128 + wr * 64 + fq * 4;
    const float* gatep = p.mod + (size_t)(l * 17 + modrow) * 3072 + 2048 + f0;
    {
      f32x4 gt[4];
#pragma unroll
      for (int m = 0; m < 4; ++m) gt[m] = *(const f32x4*)(gatep + m * 16);
#pragma unroll
      for (int g = 0; g < 4; ++g)
#pragma unroll
        for (int m = 0; m < 4; ++m)
#pragma unroll
          for (int j = 0; j < 4; ++j) acc[ai][g >> 1][m][g & 1][j] *= gt[m][j];
    }
    __builtin_amdgcn_sched_barrier(0);
    f32x4 gs[4], rgs[4];
#pragma unroll
    for (int m = 0; m < 4; ++m) {
      if (!L0) {
        const f32x4 g0 = *(const f32x4*)(p.norm_gain + (size_t)l * DM + f0 + m * 16);
        const f32x4 s0 = *(const f32x4*)(p.mod + (size_t)(l * 17 + modrow) * 3072 + 1024 + f0 + m * 16);
#pragma unroll
        for (int j = 0; j < 4; ++j) rgs[m][j] = __builtin_amdgcn_rcpf(g0[j] * (1.f + s0[j]));
      }
      if (HN) {
        const f32x4 g1 = *(const f32x4*)(p.norm_gain + (size_t)(l + 1) * DM + f0 + m * 16);
        const f32x4 s1 = *(const f32x4*)(p.mod + (size_t)((l + 1) * 17 + modrow) * 3072 + 1024 + f0 + m * 16);
#pragma unroll
        for (int j = 0; j < 4; ++j) gs[m][j] = g1[j] * (1.f + s1[j]);
      }
    }
#pragma unroll
    for (int gp = 0; gp < 2; ++gp) {
      f32x4 xv[2][4];
      u32x2 xb[2][4];
#pragma unroll
      for (int n = 0; n < 2; ++n)
#pragma unroll
        for (int m = 0; m < 4; ++m) {
          if (L0) xv[n][m] = *(const f32x4*)(xin0 + (size_t)(tok[gp * 2 + n] - rowoff) * DM + f0 + m * 16);
          else xb[n][m] = *(const u32x2*)(p.xg + (size_t)tok[gp * 2 + n] * DM + f0 + m * 16);
        }
#pragma unroll
      for (int n = 0; n < 2; ++n) {
        const int g = gp * 2 + n;
        float ss = 0.f;
#pragma unroll
        for (int m = 0; m < 4; ++m) {
          f32x4 xx;
          if (L0) xx = xv[n][m];
          else {
            xx[0] = hlo(xb[n][m][0]) * rgs[m][0]; xx[1] = hhi(xb[n][m][0]) * rgs[m][1];
            xx[2] = hlo(xb[n][m][1]) * rgs[m][2]; xx[3] = hhi(xb[n][m][1]) * rgs[m][3];
          }
          f32x4 nv;
#pragma unroll
          for (int j = 0; j < 4; ++j) { nv[j] = xx[j] + acc[ai][gp][m][n][j]; ss += nv[j] * nv[j]; }
          if (HN) {
            u32x2 o;
            o[0] = pkh2(nv[0] * gs[m][0], nv[1] * gs[m][1]);
            o[1] = pkh2(nv[2] * gs[m][2], nv[3] * gs[m][3]);
            *(u32x2*)(p.xg + (size_t)tok[g] * DM + f0 + m * 16) = o;
          } else {
            *(f32x4*)(p.out + (size_t)tok[g] * DM + f0 + m * 16) = nv;
          }
        }
        if (HN) {
          ss += __shfl_xor(ss, 16);
          ss += __shfl_xor(ss, 32);
          if (fq == 0) p.ssq[(size_t)tok[g] * 16 + (n0 >> 6) + ai * 2 + wr] = ss;
        }
      }
    }
  }
}

DI void phaseC_tile(const Params& p0, int l, int ft, int mt, char* lds) {
  f32x4 acc[2][2][4][2];
  zero_acc(acc);
  gemm256<false>(p0.WoutT + (size_t)l * DM * DM, p0.Y, ft * 256, mt * 256, lds, acc);
  launder_s(l); launder_s(ft); launder_s(mt);
  Params p; reload_params(p);
  if (l + 1 < NL) phaseC_epi<true, false>(p, acc, l, ft * 256, mt * 256);
  else phaseC_epi<false, false>(p, acc, l, ft * 256, mt * 256);
}

template <bool NA, bool TRACK>
DI void attn_item(char* lds, const bf16_t* P, bf16_t* Y, const bf16_t* vt, int rp, int q_off, int k1_off, int nt1,
                  int vk1, int k2_off, int nt2, int vk2, int g_off, int y_off, int rlo, const float* rpb) {
  asm volatile("" : "+v"(q_off), "+v"(g_off), "+v"(y_off));
  const bf16_t* qp = P + q_off;
  const bf16_t* kp1 = P + k1_off;
  const bf16_t* kp2 = P + k2_off;
  const int tid = get_tid(), lane = tid & 63, w = tid >> 6, r = lane & 31, h = lane >> 5;
  const int lr = tid >> 3, lc = tid & 7;
  const int nt = nt1 + nt2;
  const int woff = lr * 128 + ((lc ^ ((lr >> 1) & 7)) << 4);
  const int swz = (r >> 1) & 7;
  float* tab = (float*)(lds + 131072);
  int rw = 0, r0w = 0, cq = 0, c0 = 0;
  if (NA) {
    rw = rp * 4 + (w >> 1);
    r0w = clampi(rw - 4, 0, 24);
    cq = (w & 1) * 32 + r;
    c0 = clampi(cq - 8, 0, 48);
    for (int e = tid; e < 15 * 128; e += NTHREADS) {
      const int dr = e >> 7, dc = (e & 127) - 48;
      tab[e] = (dc >= 0 && dc < 31) ? rpb[dr * 31 + dc] * LOG2E : 0.f;
    }
  }
  bf16x8 qf[4];
#pragma unroll
  for (int ks = 0; ks < 4; ++ks) qf[ks] = *(const bf16x8*)(qp + (size_t)(w * 32 + r) * INW + ks * 16 + h * 8);
  u32x2 gate[2][4];
#pragma unroll
  for (int dm = 0; dm < 2; ++dm)
#pragma unroll
    for (int g = 0; g < 4; ++g)
      gate[dm][g] = *(const u32x2*)(P + g_off + (size_t)(w * 32 + r) * INW + dm * 32 + 8 * g + 4 * h);
#pragma unroll
  for (int ks = 0; ks < 4; ++ks) asm volatile("" : "+v"(qf[ks]));
#pragma unroll
  for (int dm = 0; dm < 2; ++dm)
#pragma unroll
    for (int g = 0; g < 4; ++g) asm volatile("" : "+v"(gate[dm][g]));
  f32x16 o[2];
  o[0] = zero16(); o[1] = zero16();
  f32x16 negm;
#pragma unroll
  for (int i = 0; i < 16; ++i) negm[i] = 0.f;
  float l_run = 0.f;

  constexpr int TPI = 4;
  const int niter = (nt + TPI - 1) / TPI;
  u32x4 rk[TPI], rv[TPI];
#define ATT_LOAD(IT) do { _Pragma("unroll") for (int j_ = 0; j_ < TPI; ++j_) { const int t_ = (IT) * TPI + j_; if (t_ < nt) { \
      const bf16_t* kp_; int vk_; \
      if (t_ < nt1) { kp_ = kp1 + (size_t)t_ * 64 * INW; vk_ = vk1 + t_ * 64; } \
      else { kp_ = kp2 + (size_t)(t_ - nt1) * 64 * INW; vk_ = vk2 + (t_ - nt1) * 64; } \
      rk[j_] = *(const u32x4*)(kp_ + (size_t)lr * INW + lc * 8); \
      rv[j_] = *(const u32x4*)(vt + (size_t)lr * KEYS + vk_ + lc * 8); } } } while (0)
#define ATT_WRITE(IT, HALF) do { _Pragma("unroll") for (int j_ = 0; j_ < TPI; ++j_) { const int t_ = (IT) * TPI + j_; if (t_ < nt) { \
      char* sl_ = lds + (HALF) * 65536 + j_ * 16384; \
      *(u32x4*)(sl_ + woff) = rk[j_]; \
      *(u32x4*)(sl_ + 8192 + woff) = rv[j_]; } } } while (0)
  ATT_LOAD(0);
  ATT_WRITE(0, 0);
  __syncthreads();
  for (int it = 0; it < niter; ++it) {
    const int hb = it & 1;
    if constexpr (NA || TRACK) { if (it + 1 < niter) ATT_LOAD(it + 1); }
    if constexpr (!NA && !TRACK) {
#define ATT_LOAD2(IT, H) do { _Pragma("unroll") for (int j_ = 0; j_ < 2; ++j_) { const int t_ = (IT) * TPI + 2 * (H) + j_; \
      const bf16_t* kp_; int vk_; \
      if (t_ < nt1) { kp_ = kp1 + (size_t)t_ * 64 * INW; vk_ = vk1 + t_ * 64; } \
      else { kp_ = kp2 + (size_t)(t_ - nt1) * 64 * INW; vk_ = vk2 + (t_ - nt1) * 64; } \
      rk[j_] = *(const u32x4*)(kp_ + (size_t)lr * INW + lc * 8); \
      rv[j_] = *(const u32x4*)(vt + (size_t)lr * KEYS + vk_ + lc * 8); } } while (0)
#define ATT_WRITE2(HALF, H) do { _Pragma("unroll") for (int j_ = 0; j_ < 2; ++j_) { \
      char* sl_ = lds + (HALF) * 65536 + (2 * (H) + j_) * 16384; \
      *(u32x4*)(sl_ + woff) = rk[j_]; \
      *(u32x4*)(sl_ + 8192 + woff) = rv[j_]; } } while (0)
      const bool more = it + 1 < niter;
      if (more) ATT_LOAD2(it + 1, 0);
      const char* Kb = lds + hb * 65536;
      f32x16 sc[2], sn[2];
#define ATT_QK(S, J) do { const char* Kp_ = Kb + (J) * 16384; bf16x8 kf_[8]; \
        _Pragma("unroll") for (int kt_ = 0; kt_ < 2; ++kt_) _Pragma("unroll") for (int ks_ = 0; ks_ < 4; ++ks_) \
          kf_[kt_ * 4 + ks_] = *(const bf16x8*)(Kp_ + (kt_ * 32 + r) * 128 + (((2 * ks_ + h) ^ swz) << 4)); \
        _Pragma("unroll") for (int kt_ = 0; kt_ < 2; ++kt_) { \
          S[kt_] = mfma32(kf_[kt_ * 4], qf[0], zero16()); \
          _Pragma("unroll") for (int ks_ = 1; ks_ < 4; ++ks_) S[kt_] = mfma32(kf_[kt_ * 4 + ks_], qf[ks_], S[kt_]); } } while (0)
      ATT_QK(sc, 0);
#pragma unroll
      for (int j = 0; j < TPI; ++j) {
        const char* Vs = Kb + j * 16384 + 8192;
        if (j + 1 < TPI) ATT_QK(sn, j + 1);
        float ps = 0.f;
#pragma unroll
        for (int kt = 0; kt < 2; ++kt) {
          bf16x8 vf[4];
#pragma unroll
          for (int sp = 0; sp < 2; ++sp)
#pragma unroll
            for (int dm = 0; dm < 2; ++dm)
              vf[sp * 2 + dm] = *(const bf16x8*)(Vs + (dm * 32 + r) * 128 + (((4 * kt + 2 * sp + h) ^ swz) << 4));
#pragma unroll
          for (int i = 0; i < 16; ++i) {
            const float pv = fast_exp2(sc[kt][i]);
            ps += pv;
            sc[kt][i] = pv;
          }
#pragma unroll
          for (int sp = 0; sp < 2; ++sp) {
            u32x4 pu;
            pu[0] = pk2(sc[kt][8 * sp + 0], sc[kt][8 * sp + 1]);
            pu[1] = pk2(sc[kt][8 * sp + 2], sc[kt][8 * sp + 3]);
            pu[2] = pk2(sc[kt][8 * sp + 4], sc[kt][8 * sp + 5]);
            pu[3] = pk2(sc[kt][8 * sp + 6], sc[kt][8 * sp + 7]);
            const bf16x8 pf = __builtin_bit_cast(bf16x8, pu);
#pragma unroll
            for (int dm = 0; dm < 2; ++dm) o[dm] = mfma32(vf[sp * 2 + dm], pf, o[dm]);
          }
        }
        l_run += ps;
        if (j + 1 < TPI) { sc[0] = sn[0]; sc[1] = sn[1]; }
        if (j == 1 && more) { ATT_WRITE2(hb ^ 1, 0); ATT_LOAD2(it + 1, 1); }
      }
      if (more) ATT_WRITE2(hb ^ 1, 1);
#undef ATT_QK
#undef ATT_LOAD2
#undef ATT_WRITE2
    } else
#pragma unroll 1
    for (int j = 0; j < TPI; ++j) {
      const int t = it * TPI + j;
      if (t >= nt) break;
      bool active = true;
      int drow = 0;
      if (NA && t < nt1) {
        const int R = rlo + t;
        active = (R >= r0w) && (R < r0w + 8);
        drow = R - rw + 7;
      }
      if (active) {
        const char* Ks = lds + hb * 65536 + j * 16384;
        const char* Vs = Ks + 8192;
        bf16x8 kf[8];
#pragma unroll
        for (int kt = 0; kt < 2; ++kt)
#pragma unroll
          for (int ks = 0; ks < 4; ++ks)
            kf[kt * 4 + ks] = *(const bf16x8*)(Ks + (kt * 32 + r) * 128 + (((2 * ks + h) ^ swz) << 4));
        __builtin_amdgcn_sched_barrier(0);
        f32x16 s[2];
        __builtin_amdgcn_s_setprio(1);
#pragma unroll
        for (int kt = 0; kt < 2; ++kt) {
          s[kt] = mfma32(kf[kt * 4], qf[0], negm);
#pragma unroll
          for (int ks = 1; ks < 4; ++ks) s[kt] = mfma32(kf[kt * 4 + ks], qf[ks], s[kt]);
        }
        __builtin_amdgcn_s_setprio(0);
        bf16x8 vf[8];
#pragma unroll
        for (int kt = 0; kt < 2; ++kt)
#pragma unroll
          for (int sp = 0; sp < 2; ++sp)
#pragma unroll
            for (int dm = 0; dm < 2; ++dm)
              vf[(kt * 2 + sp) * 2 + dm] = *(const bf16x8*)(Vs + (dm * 32 + r) * 128 + (((4 * kt + 2 * sp + h) ^ swz) << 4));
        __builtin_amdgcn_sched_barrier(0);
        if (NA) {
          if (t < nt1) {
            const float* trow = tab + drow * 128 + 63 - cq;
#pragma unroll
            for (int kt = 0; kt < 2; ++kt)
#pragma unroll
              for (int i = 0; i < 16; ++i) {
                const int kc = kt * 32 + (i & 3) + 8 * (i >> 2) + 4 * h;
                const bool ok = (unsigned)(kc - c0) < 16u;
                const float t2 = s[kt][i] + trow[kc];
                s[kt][i] = ok ? t2 : -1e30f;
              }
          }
        }
        float mx = 0.f;
        if (TRACK) {
          mx = fmaxf(s[0][0], s[1][0]);
#pragma unroll
          for (int i = 1; i < 16; ++i) mx = fmaxf(fmaxf(mx, s[0][i]), s[1][i]);
          mx = fmaxf(mx, __shfl_xor(mx, 32));
        }
        if (TRACK && __any(mx > 8.f)) {
          const float dlt = fmaxf(mx, 0.f);
          const float alpha = fast_exp2(-dlt);
          l_run *= alpha;
#pragma unroll
          for (int i = 0; i < 16; ++i) { o[0][i] *= alpha; o[1][i] *= alpha; negm[i] -= dlt; }
#pragma unroll
          for (int i = 0; i < 16; ++i) { s[0][i] -= dlt; s[1][i] -= dlt; }
        }
        float ps = 0.f;
#pragma unroll
        for (int kt = 0; kt < 2; ++kt)
#pragma unroll
          for (int i = 0; i < 16; ++i) {
            const float pv = fast_exp2(s[kt][i]);
            ps += pv;
            s[kt][i] = pv;
          }
        l_run += ps;
#pragma unroll
        for (int kt = 0; kt < 2; ++kt)
#pragma unroll
          for (int sp = 0; sp < 2; ++sp) {
            u32x4 pu;
            pu[0] = pk2(s[kt][8 * sp + 0], s[kt][8 * sp + 1]);
            pu[1] = pk2(s[kt][8 * sp + 2], s[kt][8 * sp + 3]);
            pu[2] = pk2(s[kt][8 * sp + 4], s[kt][8 * sp + 5]);
            pu[3] = pk2(s[kt][8 * sp + 6], s[kt][8 * sp + 7]);
            const bf16x8 pf = __builtin_bit_cast(bf16x8, pu);
#pragma unroll
            for (int dm = 0; dm < 2; ++dm) o[dm] = mfma32(vf[(kt * 2 + sp) * 2 + dm], pf, o[dm]);
          }
      }
    }
    if constexpr (NA || TRACK) { if (it + 1 < niter) ATT_WRITE(it + 1, hb ^ 1); }
    __syncthreads();
  }
#undef ATT_LOAD
#undef ATT_WRITE
  const float lt = l_run + __shfl_xor(l_run, 32);
  const float inv = 1.f / lt;
  int row = w * 32 + r;
  asm volatile("" : "+v"(row));
  bf16_t* yp = Y + y_off;
#pragma unroll
  for (int dm = 0; dm < 2; ++dm) {
    u32x2 ov[4];
#pragma unroll
    for (int g = 0; g < 4; ++g) {
      const u32x2 gv = gate[dm][g];
      ov[g][0] = pk2(o[dm][4 * g + 0] * inv * bflo(gv[0]), o[dm][4 * g + 1] * inv * bfhi(gv[0]));
      ov[g][1] = pk2(o[dm][4 * g + 2] * inv * bflo(gv[1]), o[dm][4 * g + 3] * inv * bfhi(gv[1]));
    }
#pragma unroll
    for (int a = 0; a < 2; ++a) {
      const int ga = 2 * a, gb = 2 * a + 1;
      const unsigned s0 = h ? ov[ga][0] : ov[gb][0], s1 = h ? ov[ga][1] : ov[gb][1];
      const unsigned r0 = (unsigned)__shfl_xor((int)s0, 32), r1 = (unsigned)__shfl_xor((int)s1, 32);
      u32x4 wv;
      wv[0] = h ? r0 : ov[ga][0];
      wv[1] = h ? r1 : ov[ga][1];
      wv[2] = h ? ov[gb][0] : r0;
      wv[3] = h ? ov[gb][1] : r1;
      *(u32x4*)(yp + (size_t)row * DM + dm * 32 + 8 * (ga + h)) = wv;
    }
  }
}

DI void pool_item(const Params& p, int l, int token0, char* lds) {
  const int tid = get_tid(), lane = tid & 63, w = tid >> 6, r = lane & 31, h = lane >> 5;
  int seqbase, L;
  if (token0 < NLAT) { seqbase = (token0 / SEQ) * SEQ; L = SEQ; }
  else { seqbase = NLAT + ((token0 - NLAT) / CTX) * CTX; L = CTX; }
  const int s0 = token0 - seqbase;
  char* zt = lds;
  char* pl = lds + 40960;
  f32x4 scp[2][4];
  u32x2 gvp[2][4];
  {
    const int g_ = w & 3, tok_ = token0 + (w >> 2) * 32 + r;
#pragma unroll
    for (int mo = 0; mo < 2; ++mo)
#pragma unroll
      for (int gg = 0; gg < 4; ++gg) {
        const int oc = mo * 32 + 8 * gg + 4 * h;
        scp[mo][gg] = *(const f32x4*)(p.pool_scale + l * 256 + g_ * 64 + oc);
        gvp[mo][gg] = *(const u32x2*)(p.P + (size_t)tok_ * INW + 1536 + g_ * 64 + oc);
      }
  }
  for (int e = tid; e < 80 * 32; e += NTHREADS) {
    const int row = e >> 5, ch = e & 31;
    const int s = s0 - 8 + row;
    u32x4 v = {0u, 0u, 0u, 0u};
    if (s >= 0 && s < L) v = *(const u32x4*)(p.P + (size_t)(seqbase + s) * INW + 1280 + ch * 8);
    *(u32x4*)(zt + row * 512 + ch * 16) = v;
  }
  __syncthreads();
  for (int e = tid; e < 64 * 32; e += NTHREADS) {
    const int tl = e >> 5, ch = e & 31;
    const int g = ch >> 3;
    const int hw = 1 << g;
    const int s = s0 + tl;
    int lo = s - hw; lo = lo < 0 ? 0 : lo;
    int hi = s + hw - 1; hi = hi > L - 1 ? L - 1 : hi;
    float sum[8];
#pragma unroll
    for (int j = 0; j < 8; ++j) sum[j] = 0.f;
    for (int q = lo; q <= hi; ++q) {
      const u32x4 v = *(const u32x4*)(zt + (q - s0 + 8) * 512 + ch * 16);
#pragma unroll
      for (int j = 0; j < 4; ++j) { sum[2 * j] += bflo(v[j]); sum[2 * j + 1] += bfhi(v[j]); }
    }
    const float ic = 1.f / (float)(hi - lo + 1);
    const u32x4 zc = *(const u32x4*)(zt + (tl + 8) * 512 + ch * 16);
    u32x4 ov;
#pragma unroll
    for (int j = 0; j < 4; ++j)
      ov[j] = pk2(sum[2 * j] * ic - bflo(zc[j]), sum[2 * j + 1] * ic - bfhi(zc[j]));
    *(u32x4*)(pl + tl * 512 + ((ch ^ (tl & 15)) << 4)) = ov;
  }
  __syncthreads();
  {
    const int g = w & 3, tn0 = w >> 2;
    f32x16 acc[2][2];
#pragma unroll
    for (int a = 0; a < 2; ++a)
#pragma unroll
      for (int b = 0; b < 2; ++b) acc[a][b] = zero16();
    const bf16_t* wp = p.pwT + (size_t)((l * 4 + g) * 64) * 64;
#pragma unroll
    for (int ks = 0; ks < 4; ++ks) {
      bf16x8 a[2], b[2];
#pragma unroll
      for (int mo = 0; mo < 2; ++mo) a[mo] = *(const bf16x8*)(wp + (size_t)(mo * 32 + r) * 64 + ks * 16 + h * 8);
      {
        const int row = tn0 * 32 + r;
        const int ch = g * 8 + 2 * ks + h;
        b[0] = *(const bf16x8*)(pl + row * 512 + ((ch ^ (row & 15)) << 4));
      }
#pragma unroll
      for (int mo = 0; mo < 2; ++mo) acc[mo][0] = mfma32(a[mo], b[0], acc[mo][0]);
    }
    {
      const int tn = 0;
      const int token = token0 + tn0 * 32 + r;
#pragma unroll
      for (int mo = 0; mo < 2; ++mo)
#pragma unroll
        for (int gg = 0; gg < 4; ++gg) {
          const int oc = mo * 32 + 8 * gg + 4 * h;
          const f32x4 sc = scp[mo][gg];
          const u32x2 gv = gvp[mo][gg];
          u32x2 ov;
          ov[0] = pk2(acc[mo][tn][4 * gg + 0] * sc[0] * bflo(gv[0]), acc[mo][tn][4 * gg + 1] * sc[1] * bfhi(gv[0]));
          ov[1] = pk2(acc[mo][tn][4 * gg + 2] * sc[2] * bflo(gv[1]), acc[mo][tn][4 * gg + 3] * sc[3] * bfhi(gv[1]));
          *(u32x2*)(p.Y + (size_t)token * DM + 512 + g * 64 + oc) = ov;
        }
    }
  }
  __syncthreads();
}

DI void gemv17(const float* in16, int istride, const float* in1, bool do_silu, const float* W, int ldw, int n0,
               const float* bvec, float* out, int ostride, char* lds) {
  const int tid = get_tid(), col = tid & 63, kp = tid >> 6;
  float* sc = (float*)lds;
  float* red = (float*)(lds + 34816);
  float acc[17];
#pragma unroll
  for (int j = 0; j < 17; ++j) acc[j] = 0.f;
  for (int kh = 0; kh < 2; ++kh) {
    __syncthreads();
    for (int e = tid; e < 17 * 512; e += NTHREADS) {
      const int j = e >> 9, k = e & 511;
      float v = (j < 16) ? in16[(size_t)j * istride + kh * 512 + k] : in1[kh * 512 + k];
      if (do_silu) v = v / (1.f + expf(-v));
      sc[e] = v;
    }
    __syncthreads();
    const float* wp = W + (size_t)(kh * 512 + kp * 64) * ldw + n0 + col;
#pragma unroll 16
    for (int kk = 0; kk < 64; ++kk) {
      const float wv = wp[(size_t)kk * ldw];
      const float* sp = sc + kp * 64 + kk;
#pragma unroll
      for (int j = 0; j < 17; ++j) acc[j] += sp[j * 512] * wv;
    }
  }
#pragma unroll
  for (int j = 0; j < 17; ++j) red[(kp * 17 + j) * 64 + col] = acc[j];
  __syncthreads();
  for (int e = tid; e < 17 * 64; e += NTHREADS) {
    const int j = e >> 6, cc = e & 63;
    float v = ((red[(0 * 17 + j) * 64 + cc] + red[(1 * 17 + j) * 64 + cc]) +
               (red[(2 * 17 + j) * 64 + cc] + red[(3 * 17 + j) * 64 + cc])) +
              ((red[(4 * 17 + j) * 64 + cc] + red[(5 * 17 + j) * 64 + cc]) +
               (red[(6 * 17 + j) * 64 + cc] + red[(7 * 17 + j) * 64 + cc]));
    if (bvec) v += bvec[n0 + cc];
    out[(size_t)j * ostride + n0 + cc] = v;
  }
  __syncthreads();
}

DI void transpose_strip(const float* W, int ldn, int k0, int n0, bf16_t* WT, char* lds, bool f16) {
  const int tid = get_tid();
  float* tl = (float*)lds;
  const int nn = tid & 63, kb = tid >> 6;
  float r[4][8];
#pragma unroll
  for (int t4 = 0; t4 < 4; ++t4)
#pragma unroll
    for (int i = 0; i < 8; ++i) r[t4][i] = W[(size_t)(k0 + kb + 8 * i) * ldn + n0 + t4 * 64 + nn];
#pragma unroll
  for (int t4 = 0; t4 < 4; ++t4)
#pragma unroll
    for (int i = 0; i < 8; ++i) tl[t4 * 4160 + (kb + 8 * i) * 65 + nn] = r[t4][i];
  __syncthreads();
  const int n2 = tid >> 3, ch = tid & 7;
#pragma unroll
  for (int t4 = 0; t4 < 4; ++t4) {
    u32x4 o;
#pragma unroll
    for (int j = 0; j < 4; ++j)
    {
      const float a_ = tl[t4 * 4160 + (ch * 8 + 2 * j) * 65 + n2], b_ = tl[t4 * 4160 + (ch * 8 + 2 * j + 1) * 65 + n2];
      o[j] = f16 ? pkh2(a_, b_) : pk2(a_, b_);
    }
    *(u32x4*)(WT + (size_t)(n0 + t4 * 64 + n2) * DM + k0 + ch * 8) = o;
  }
  __syncthreads();
}

DI void phase0(const Params& p, char* lds) {
  constexpr int N_MOD = NL * 48, N_TR = NL * 240, N_PW = 16;
  const int total = N_MOD + N_TR + N_PW + 1;
  for (int it = get_bid(); it < total; it += gridDim.x) {
    if (it < N_MOD) {
      const int l = it / 48, nc = it % 48;
      gemv17(p.c, DM, p.c_ctx, true, p.w_mod + (size_t)l * DM * 3072, 3072, nc * 64, p.b_mod + l * 3072,
             p.mod + (size_t)l * 17 * 3072, 3072, lds);
    } else if (it < N_MOD + N_TR) {
      const int q = it - N_MOD;
      const int l = q / 240, t = q % 240;
      if (t < 176) {
        const int kt = t / 11, ns = t % 11;
        transpose_strip(p.w_in + (size_t)l * DM * INW, INW, kt * 64, ns * 256, p.WinT + (size_t)l * INW * DM, lds, true);
      } else {
        const int t2 = t - 176;
        const int kt = t2 / 4, ns = t2 % 4;
        transpose_strip(p.w_out + (size_t)l * DM * DM, DM, kt * 64, ns * 256, p.WoutT + (size_t)l * DM * DM, lds, false);
      }
    } else if (it < N_MOD + N_TR + N_PW) {
      const int q = it - N_MOD - N_TR;
      const float* src = p.pool_w + (size_t)q * 4096;
      bf16_t* dst = p.pwT + (size_t)q * 4096;
      for (int e = get_tid(); e < 4096; e += NTHREADS) {
        const int o = e >> 6, i = e & 63;
        dst[e] = (bf16_t)(pk2(src[i * 64 + o], 0.f) & 0xffffu);
      }
    } else {
      for (int e = get_tid(); e < 64 * 16; e += NTHREADS) {
        const int pos = e >> 4, j = e & 15;
        const float inv = powf(10000.0f, -(float)j / 16.0f);
        const float ang = (float)pos * inv;
        p.rope[e * 2] = cosf(ang);
        p.rope[e * 2 + 1] = sinf(ang);
      }
    }
  }
}

DI void phase0b(const Params& p, char* lds) {
  constexpr int N_B = NL * 44;
  const int total = N_B + NTOK / 64;
  const int tid = get_tid(), lane = tid & 63, w = tid >> 6;
  for (int it = get_bid(); it < total; it += gridDim.x) {
    if (it < N_B) {
      const int l = it / 44, nc = it % 44;
      gemv17(p.mod + (size_t)l * 17 * 3072, 3072, p.mod + (size_t)(l * 17 + 16) * 3072, false,
             p.w_in + (size_t)l * DM * INW, INW, nc * 64, nullptr, p.bias + (size_t)l * 17 * INW, INW, lds);
    } else {
      const int rb = (it - N_B) * 64;
      const int modrow = rb < NLAT ? rb / SEQ : 16;
      const float* scp = p.mod + (size_t)modrow * 3072 + 1024;
      f32x4 gsv[4];
#pragma unroll
      for (int pp = 0; pp < 4; ++pp) {
        const int k = pp * 256 + lane * 4;
        const f32x4 g = *(const f32x4*)(p.norm_gain + k);
        const f32x4 sc = *(const f32x4*)(scp + k);
#pragma unroll
        for (int j = 0; j < 4; ++j) gsv[pp][j] = g[j] * (1.f + sc[j]);
      }
#pragma unroll
      for (int qb = 0; qb < 2; ++qb) {
        f32x4 xv[4][4];
#pragma unroll
        for (int q = 0; q < 4; ++q) {
          const int row = rb + w * 8 + qb * 4 + q;
          const float* src = row < NLAT ? p.x + (size_t)row * DM : p.ctx + (size_t)(row - NLAT) * DM;
#pragma unroll
          for (int pp = 0; pp < 4; ++pp) xv[q][pp] = *(const f32x4*)(src + pp * 256 + lane * 4);
        }
#pragma unroll
        for (int q = 0; q < 4; ++q) {
          const int row = rb + w * 8 + qb * 4 + q;
          float ss = 0.f;
#pragma unroll
          for (int pp = 0; pp < 4; ++pp) {
            const f32x4 v = xv[q][pp];
            ss += (v[0] * v[0] + v[1] * v[1]) + (v[2] * v[2] + v[3] * v[3]);
            u32x2 o;
            o[0] = pkh2(v[0] * gsv[pp][0], v[1] * gsv[pp][1]);
            o[1] = pkh2(v[2] * gsv[pp][2], v[3] * gsv[pp][3]);
            *(u32x2*)(p.xg + (size_t)row * DM + pp * 256 + lane * 4) = o;
          }
#pragma unroll
          for (int m = 1; m < 64; m <<= 1) ss += __shfl_xor(ss, m);
          if (lane < 16) p.ssq[(size_t)row * 16 + lane] = (lane == 0) ? ss : 0.f;
        }
      }
    }
  }
}

DI void tile_map(int it, int nF, int nT, int& pf, int& pt) {
  const int nwg = nF * nT;
  const int q = nwg / 8, r = nwg % 8, xcd = it % 8, off = it / 8;
  const int wgid = (xcd < r ? xcd * (q + 1) : r * (q + 1) + (xcd - r) * q) + off;
  constexpr int WGM = 8;
  const int nig = WGM * nT, gid = wgid / nig, fm = gid * WGM, gsz = (nF - fm) < WGM ? (nF - fm) : WGM;
  pf = fm + ((wgid % nig) % gsz);
  pt = (wgid % nig) / gsz;
}

DI void publish_count(unsigned* cnt) {
  asm volatile("s_waitcnt vmcnt(0)" ::: "memory");
  __syncthreads();
  if (get_tid() == 0) {
    __builtin_amdgcn_fence(__ATOMIC_RELEASE, "agent");
    asm volatile("s_waitcnt vmcnt(0)" ::: "memory");
    (void)__hip_atomic_fetch_add(cnt, 1u, __ATOMIC_RELAXED, __HIP_MEMORY_SCOPE_AGENT);
  }
}
DI void wait_count(unsigned* cnt, unsigned target) {
  if (get_tid() == 0) {
    while (__hip_atomic_load(cnt, __ATOMIC_RELAXED, __HIP_MEMORY_SCOPE_AGENT) < target) __builtin_amdgcn_s_sleep(1);
    __builtin_amdgcn_fence(__ATOMIC_ACQUIRE, "agent");
    asm volatile("s_waitcnt vmcnt(0)" ::: "memory");
  }
  __syncthreads();
}

DI void phaseA(const Params& p, int l, char* lds) {
  const bool last = (l == NL - 1);
  constexpr int NF = INW / 256;
  constexpr int NLT = NLAT / 256, NCT = NCTX / 256;
  const int nPre = (l > 0) ? NCT * 4 : 0;
  const int nLat = NF * NLT;
  const int nCtx = last ? NCT * 3 : NCT * NF;
  const int total = nPre + nLat + nCtx;
  unsigned* cnt = p.bar + 3584 + 64 * l;
  constexpr int PRE0 = 192;
  for (int it = get_bid(); it < total; it += gridDim.x) {
    if (nPre && it >= PRE0 && it < PRE0 + nPre) {
      const int e = it - PRE0;
      phaseC_tile(p, l - 1, e & 3, NLT + (e >> 2), lds);
      publish_count(cnt);
      continue;
    }
    int pf, pt;
    if (it < nPre + nLat) tile_map((nPre && it >= PRE0) ? it - nPre : it, NF, NLT, pf, pt);
    else {
      const int e = it - nPre - nLat;
      if (last) { pt = NLT + e / 3; const int k = e % 3; pf = (k == 0) ? 2 : (7 + k); }
      else { pt = NLT + e / NF; pf = e % NF; }
      if (nPre) wait_count(cnt, (unsigned)nPre);
    }
    phaseA_tile(p, l, pf, pt, lds);
  }
}

DI void phaseB(const Params& p, int l, char* lds) {
  const bool last = (l == NL - 1);
  const int nG = 1024, nN = 512, nCA = last ? 0 : 128, nCN = last ? 0 : 64, nP = last ? 512 : 576;
  const int nAttn = nG + nN + nCA + nCN;
  const int total = nAttn + nP;
  bool track;
  {
    const int ln = get_tid() & 63;
    float a = fabsf(p.att_q_gain[l * 64 + ln]), bq = fabsf(p.att_k_gain[l * 64 + ln]);
    float c = fabsf(p.na_q_gain[l * 64 + ln]), dk = fabsf(p.na_k_gain[l * 64 + ln]);
#pragma unroll
    for (int m = 1; m < 64; m <<= 1) {
      a = fmaxf(a, __shfl_xor(a, m)); bq = fmaxf(bq, __shfl_xor(bq, m));
      c = fmaxf(c, __shfl_xor(c, m)); dk = fmaxf(dk, __shfl_xor(dk, m));
    }
    const float bound = 64.f * 0.125f * LOG2E * 1.02f * fmaxf(a * bq, c * dk);
    track = !(__builtin_amdgcn_readfirstlane(__float_as_int(bound)) <= __float_as_int(40.f));
  }
  for (int it = get_bid(); it < total; it += gridDim.x) {
    if (it >= nAttn) { pool_item(p, l, (it - nAttn) * 64, lds); continue; }
    int idx = it;
    bool na = false, isN;
    int rq = 0, b, head, kvh, qrow, k1row = 0, nt1 = 0, vk1 = 0, rlo = 0;
    if (idx < nG) {
      const int rd = idx >> 8, j = idx & 255, xx = j & 7, y = j >> 3;
      const int grp = rd * 8 + xx;
      b = grp >> 1; kvh = grp & 1; head = kvh * 4 + (y >> 3);
      qrow = b * SEQ + (y & 7) * 256; k1row = b * SEQ; nt1 = 32; vk1 = 0; isN = false;
    } else if (idx < nG + nN) {
      idx -= nG;
      b = idx >> 5; const int rem = idx & 31; head = rem >> 3; kvh = head; rq = rem & 7;
      rlo = clampi(4 * rq - 4, 0, 24);
      const int rhi = clampi(4 * rq + 3 - 4, 0, 24);
      nt1 = rhi + 8 - rlo; qrow = b * SEQ + rq * 256; k1row = b * SEQ + rlo * 64; vk1 = rlo * 64; isN = true; na = true;
    } else if (idx < nG + nN + nCA) {
      idx -= nG + nN;
      b = idx >> 3; head = idx & 7; kvh = head >> 2; qrow = NLAT + b * CTX; isN = false;
    } else {
      idx -= nG + nN + nCA;
      b = idx >> 2; head = idx & 3; kvh = head; qrow = NLAT + b * CTX; isN = true;
    }
    const int qcol = isN ? 1792 + head * 64 : head * 64;
    const int kcol = isN ? 2048 + kvh * 64 : 512 + kvh * 64;
    const int gcol = isN ? 2560 + head * 64 : 768 + head * 64;
    const int ycol = isN ? 768 + head * 64 : head * 64;
    const bf16_t* vt = isN ? p.VtN + (size_t)((b * 4 + kvh) * 64) * KEYS : p.VtA + (size_t)((b * 2 + kvh) * 64) * KEYS;
    if (na)
      attn_item<true, true>(lds, p.P, p.Y, vt, rq, qrow * INW + qcol, k1row * INW + kcol, nt1, vk1,
                            (NLAT + b * CTX) * INW + kcol, 4, SEQ, qrow * INW + gcol, qrow * DM + ycol, rlo,
                            p.na_rpb + (size_t)(l * 4 + head) * 465);
    else if (track)
      attn_item<false, true>(lds, p.P, p.Y, vt, rq, qrow * INW + qcol, k1row * INW + kcol, nt1, vk1,
                             (NLAT + b * CTX) * INW + kcol, 4, SEQ, qrow * INW + gcol, qrow * DM + ycol, rlo, nullptr);
    else
      attn_item<false, false>(lds, p.P, p.Y, vt, rq, qrow * INW + qcol, k1row * INW + kcol, nt1, vk1,
                              (NLAT + b * CTX) * INW + kcol, 4, SEQ, qrow * INW + gcol, qrow * DM + ycol, rlo, nullptr);
  }
}

DI void phaseC(const Params& p, int l, char* lds) {
  constexpr int nT = NLAT / 256;
  const int total = 4 * nT;
  for (int it = get_bid(); it < total; it += gridDim.x) {
    int pf, pt;
    tile_map(it, 4, nT, pf, pt);
    phaseC_tile(p, l, pf, pt, lds);
  }
}

DI void grid_bar(unsigned* bar, unsigned target) {
  asm volatile("s_waitcnt vmcnt(0)" ::: "memory");
  __syncthreads();
  if (get_tid() == 0) {
    __builtin_amdgcn_fence(__ATOMIC_RELEASE, "agent");
    asm volatile("s_waitcnt vmcnt(0)" ::: "memory");
    (void)__hip_atomic_fetch_add(bar, 1u, __ATOMIC_RELAXED, __HIP_MEMORY_SCOPE_AGENT);
    while (__hip_atomic_load(bar, __ATOMIC_RELAXED, __HIP_MEMORY_SCOPE_AGENT) < target) __builtin_amdgcn_s_sleep(1);
    __builtin_amdgcn_fence(__ATOMIC_ACQUIRE, "agent");
    asm volatile("s_waitcnt vmcnt(0)" ::: "memory");
  }
  __syncthreads();
}


#define XB_TMO      128
#define XB_XCNT(j)  (256  + 64 * (j))
#define XB_XSUB(j)  (1280 + 64 * (j))
#define XB_XGEN(j)  (2304 + 64 * (j))
#define XB_TOP      3328
#define XB_TOPGEN   3392
#define XB_SPIN_CAP (1u << 22)
typedef volatile __attribute__((address_space(3))) unsigned* xb_lds_p;
DI unsigned xb_ld(unsigned* p) { return __hip_atomic_load(p, __ATOMIC_RELAXED, __HIP_MEMORY_SCOPE_AGENT); }
DI unsigned xb_add(unsigned* p, unsigned v) { return __hip_atomic_fetch_add(p, v, __ATOMIC_RELAXED, __HIP_MEMORY_SCOPE_AGENT); }
DI unsigned xb_xcc_id() { return (unsigned)__builtin_amdgcn_s_getreg((3 << 11) | 20) & 0xFu; }
#define XB_SPIN(cond, bar) do { unsigned _sp = 0; while (cond) { __builtin_amdgcn_s_sleep(1); \
    if ((++_sp & 255u) == 0u) { if (xb_ld(&(bar)[XB_TMO])) break; if (_sp > XB_SPIN_CAP) { atomicAdd(&(bar)[XB_TMO], 1u); break; } } } } while (0)

DI void xcd_barrier_post(unsigned* bar) {
  if (get_tid() == 0) (void)xb_add(&bar[XB_XCNT(xb_xcc_id())], 1u);
}
DI void xcd_barrier_complete(unsigned* bar, unsigned x, unsigned& nloc, unsigned& nx) {
  const unsigned G = gridDim.x * gridDim.y * gridDim.z;
  unsigned sum, cnt, mine, sp = 0u;
  for (;;) {
    sum = 0u; cnt = 0u; mine = 0u;
#pragma unroll
    for (unsigned j = 0; j < 16; ++j) { const unsigned c = xb_ld(&bar[XB_XCNT(j)]); sum += c; cnt += (c > 0u) ? 1u : 0u; mine = (j == x) ? c : mine; }
    if (sum == G) break;
    __builtin_amdgcn_s_sleep(1);
    if ((++sp & 255u) == 0u) { if (xb_ld(&bar[XB_TMO])) break; if (sp > XB_SPIN_CAP) { atomicAdd(&bar[XB_TMO], 1u); break; } }
  }
  nloc = mine > 0u ? mine : 1u; nx = cnt > 0u ? cnt : 1u;
}
DI void xcd_barrier(unsigned* bar, xb_lds_p st) {
  asm volatile("s_waitcnt vmcnt(0)" ::: "memory");
  __syncthreads();
  if (get_tid() == 0) {
    const unsigned x = xb_xcc_id();
    __builtin_amdgcn_s_waitcnt(0);
    unsigned nloc = st[0], nx = st[1];
    if (nloc == 0u) { xcd_barrier_complete(bar, x, nloc, nx); st[0] = nloc; st[1] = nx; }
    const unsigned old = xb_add(&bar[XB_XSUB(x)], 1u);
    const unsigned gen = old / nloc;
    if (old + 1u == (gen + 1u) * nloc) {
      __builtin_amdgcn_fence(__ATOMIC_RELEASE, "agent");
      asm volatile("s_waitcnt vmcnt(0)" ::: "memory");
      const unsigned og = xb_add(&bar[XB_TOP], 1u);
      const unsigned tg = og / nx;
      if (og + 1u == (tg + 1u) * nx) xb_add(&bar[XB_TOPGEN], 1u);
      else XB_SPIN(xb_ld(&bar[XB_TOPGEN]) == tg, bar);
      __builtin_amdgcn_fence(__ATOMIC_ACQUIRE, "agent");
      xb_add(&bar[XB_XGEN(x)], 1u);
      asm volatile("s_waitcnt vmcnt(0)" ::: "memory");
    } else {
      XB_SPIN(xb_ld(&bar[XB_XGEN(x)]) == gen, bar);
      __builtin_amdgcn_fence(__ATOMIC_ACQUIRE, "agent");
      asm volatile("s_waitcnt vmcnt(0)" ::: "memory");
    }
  }
  __syncthreads();
}

constexpr int NPHASE = 2 + 3 * NL;
__global__ void __launch_bounds__(NTHREADS, 2) fwd_kernel(Params p_arg, int ph_begin, int ph_end) {
  __shared__ __attribute__((aligned(16))) char lds[LDS_BYTES];
  (void)p_arg;
#if defined(__HIP_DEVICE_COMPILE__)
  xb_lds_p xst = (xb_lds_p)(lds + 131072 + 7680);
  {
    Params p0_;
    reload_params(p0_);
    if (get_tid() == 0) { xst[0] = 0u; xst[1] = 0u; }
    __syncthreads();
    xcd_barrier_post(p0_.bar);
  }
  for (int ph = ph_begin; ph < ph_end; ++ph) {
    Params p;
    reload_params(p);
    if (ph == 0) phase0(p, lds);
    else if (ph == 1) phase0b(p, lds);
    else {
      const int l = (ph - 2) / 3, k = (ph - 2) % 3;
      if (k == 0) phaseA(p, l, lds);
      else if (k == 1) phaseB(p, l, lds);
      else phaseC(p, l, lds);
    }
    if (ph + 1 < ph_end) {
      if (ph_end > 1000) cg::this_grid().sync();
      xcd_barrier(p.bar, xst);
    }
  }
#endif
}

static inline size_t align_up(size_t v, size_t a) { return (v + a - 1) / a * a; }

extern "C" void kernel_launch(void* const* d_in, const int* in_sizes, int n_in, void* d_out, int out_size, void* d_ws,
                              size_t ws_size, hipStream_t stream) {
  (void)in_sizes; (void)n_in; (void)out_size; (void)ws_size;
  Params p{};
  p.x = (const float*)d_in[0]; p.c = (const float*)d_in[1]; p.ctx = (const float*)d_in[2]; p.c_ctx = (const float*)d_in[3];
  p.norm_gain = (const float*)d_in[4]; p.w_mod = (const float*)d_in[5]; p.b_mod = (const float*)d_in[6];
  p.w_in = (const float*)d_in[7]; p.att_q_gain = (const float*)d_in[8]; p.att_k_gain = (const float*)d_in[9];
  p.pool_w = (const float*)d_in[10]; p.pool_scale = (const float*)d_in[11]; p.na_q_gain = (const float*)d_in[12];
  p.na_k_gain = (const float*)d_in[13]; p.na_rpb = (const float*)d_in[14]; p.w_out = (const float*)d_in[15];
  p.out = (float*)d_out;
  char* ws = (char*)d_ws;
  size_t off = 0;
  auto take = [&](size_t bytes) { char* q = ws + off; off = align_up(off + bytes, 256); return q; };
  p.bar = (unsigned*)take(16384);
  p.WinT = (bf16_t*)take((size_t)NL * INW * DM * 2);
  p.WoutT = (bf16_t*)take((size_t)NL * DM * DM * 2);
  p.pwT = (bf16_t*)take((size_t)NL * 4 * 64 * 64 * 2);
  p.xg = (bf16_t*)take((size_t)NTOK * DM * 2);
  p.P = (bf16_t*)take((size_t)NTOK * INW * 2);
  p.VtA = (bf16_t*)take((size_t)NB * 2 * 64 * KEYS * 2);
  p.VtN = (bf16_t*)take((size_t)NB * 4 * 64 * KEYS * 2);
  p.Y = (bf16_t*)take((size_t)NTOK * DM * 2);
  p.mod = (float*)take((size_t)NL * 17 * 3072 * 4);
  p.bias = (float*)take((size_t)NL * 17 * INW * 4);
  p.rope = (float*)take((size_t)64 * 16 * 2 * 4);
  p.Cbuf = (float*)take((size_t)NCTX * DM * 4);
  p.ssq = (float*)take((size_t)NTOK * 16 * 4);

  static int grid_blocks = 0;
  if (!grid_blocks) {
    int dev = 0, cus = 0, per_cu = 0;
    hipGetDevice(&dev);
    hipDeviceGetAttribute(&cus, hipDeviceAttributeMultiprocessorCount, dev);
    hipOccupancyMaxActiveBlocksPerMultiprocessor(&per_cu, fwd_kernel, NTHREADS, 0);
    if (per_cu > 1) per_cu = 1;
    if (per_cu < 1) per_cu = 1;
    grid_blocks = cus * per_cu;
  }
  hipMemsetAsync(p.bar, 0, 16384, stream);
#ifdef MULTI_LAUNCH
  for (int ph = 0; ph < NPHASE; ++ph) {
    hipLaunchKernelGGL(fwd_kernel, dim3(grid_blocks), dim3(NTHREADS), 0, stream, p, ph, ph + 1);
  }
#else
  int pb = 0, pe = NPHASE;
  void* args[] = {&p, &pb, &pe};
  hipError_t e = hipLaunchCooperativeKernel((void*)fwd_kernel, dim3(grid_blocks), dim3(NTHREADS), args, 0, stream);
  if (e != hipSuccess) fprintf(stderr, "cooperative launch failed: %s (grid %d)\n", hipGetErrorString(e), grid_blocks);
#endif
}
```
